# Optimizing an MI355X kernel written in HIP

```python
import math
import jax
import jax.numpy as jnp
from jax import lax
import numpy as np

D_MODEL = 1024
BATCH = 16
SEQ = 2048
DEPTH = 2

GRID_W = 64
CTX_LEN = 256
HEAD_DIM = 64
MIX_WIDTH = D_MODEL
GROUP_WIDTH = MIX_WIDTH // 2
FFN_HIDDEN = 4 * D_MODEL
ROPE_BASE = 10000.0
LN_EPS = 1e-5

RWKV_HEADS = GROUP_WIDTH // HEAD_DIM
RWKV_DECAY_LORA = 64
RWKV_ICLR_LORA = 64
RWKV_GATE_LORA = 128
RWKV_GN_EPS = 64e-5
RWKV_COLS = 3 * GROUP_WIDTH + RWKV_DECAY_LORA + RWKV_ICLR_LORA + RWKV_GATE_LORA
RWKV_SPLITS = [GROUP_WIDTH, 2 * GROUP_WIDTH, 3 * GROUP_WIDTH,
               3 * GROUP_WIDTH + RWKV_DECAY_LORA, 3 * GROUP_WIDTH + RWKV_DECAY_LORA + RWKV_ICLR_LORA]

DIFF_HEADS = GROUP_WIDTH // (2 * HEAD_DIM)
DIFF_COLS = 3 * GROUP_WIDTH
ATTN_BLOCK = 128

SSD_HEADS = GROUP_WIDTH // HEAD_DIM
SSD_GROUPS = 2
SSD_STATE = 128
SSD_CONV = 5
SSD_CHUNK = 128
SSD_CONV_DIM = GROUP_WIDTH + 2 * SSD_GROUPS * SSD_STATE
SSD_COLS = GROUP_WIDTH + SSD_CONV_DIM + 2 * SSD_HEADS

SWA_HEADS = GROUP_WIDTH // HEAD_DIM
SWA_KV_HEADS = 2
SWA_WINDOW = 128
SWA_BLOCK = 128
SWA_COLS = GROUP_WIDTH + 2 * SWA_KV_HEADS * HEAD_DIM

AB_COLS = RWKV_COLS + DIFF_COLS
CD_COLS = SSD_COLS + SWA_COLS
N_AB = (DEPTH + 1) // 2
N_CD = DEPTH // 2
DEEPNORM_ALPHA = (2 * DEPTH) ** 0.25
DEEPNORM_BETA = (8 * DEPTH) ** -0.25

kernel_name = 'hybrid_rwkv7_diffattn_ssd_swa_prefix_dit'


def layer_norm(x, g, b, eps=LN_EPS):
    xf = x.astype(jnp.float32)
    mu = jnp.mean(xf, -1, keepdims=True)
    var = jnp.mean(jnp.square(xf - mu), -1, keepdims=True)
    return ((xf - mu) * lax.rsqrt(var + eps)).astype(x.dtype) * g + b


def rms_norm(x, g, eps=LN_EPS):
    xf = x.astype(jnp.float32)
    return (xf * lax.rsqrt(jnp.mean(xf * xf, -1, keepdims=True) + eps)).astype(x.dtype) * g


def modulate(h, shift, scale):
    return h * (1.0 + scale) + shift


def rope_1d(x, pos):
    half = x.shape[-1] // 2
    inv = ROPE_BASE ** (-jnp.arange(half, dtype=jnp.float32) / half)
    ang = pos.astype(jnp.float32)[:, None] * inv
    shape = (pos.shape[0],) + (1,) * (x.ndim - 3) + (half,)
    cos = jnp.cos(ang).reshape(shape).astype(x.dtype)
    sin = jnp.sin(ang).reshape(shape).astype(x.dtype)
    x1, x2 = x[..., :half], x[..., half:]
    return jnp.concatenate([x1 * cos - x2 * sin, x2 * cos + x1 * sin], -1)


def rope_2d(x, rows, cols):
    h = x.shape[-1] // 2
    return jnp.concatenate([rope_1d(x[..., :h], rows), rope_1d(x[..., h:], cols)], -1)


def bi_token_shift(p, mu):
    prev = jnp.pad(p, ((0, 0), (1, 0), (0, 0)))[:, :-1]
    nxt = jnp.pad(p, ((0, 0), (0, 1), (0, 0)))[:, 1:]
    return p + mu * (0.5 * (prev + nxt) - p)


def dw_conv_centred(x, w, b):
    k, ch = w.shape
    out = lax.conv_general_dilated(x, w[:, None, :], window_strides=(1,), padding=[(k // 2, k // 2)],
                                   dimension_numbers=('NWC', 'WIO', 'NWC'), feature_group_count=ch)
    return out + b


def segsum(a):
    t = a.shape[-1]
    cs = jnp.cumsum(a, -1)
    diff = cs[..., :, None] - cs[..., None, :]
    return jnp.where(jnp.tril(jnp.ones((t, t), bool)), diff, -jnp.inf)


def rwkv_scan(r, decay, k, v, a_vec, b_vec, s0, reverse, with_y):
    xs = tuple(jnp.moveaxis(t, 1, 0) for t in (r, decay, k, v, a_vec, b_vec))

    def step(s, inp):
        r_t, w_t, k_t, v_t, a_t, b_t = inp
        sa = jnp.einsum('bhvk,bhk->bhv', s, a_t)
        s = s * w_t[:, :, None, :] + sa[..., None] * b_t[:, :, None, :] + v_t[..., None] * k_t[:, :, None, :]
        y = jnp.einsum('bhvk,bhk->bhv', s, r_t) if with_y else None
        return s, y

    s_fin, ys = lax.scan(step, s0, xs, reverse=reverse)
    return (jnp.moveaxis(ys, 0, 1) if with_y else None), s_fin


def rwkv7_mixer(p_ctx, p_lat, mu, w0, w2, a0, a2, g2, k_k, k_a, r_k, gn_g, gn_b, need_ctx):
    def prep(p):
        b_, l_ = p.shape[:2]
        heads = lambda t: t.reshape(b_, l_, RWKV_HEADS, HEAD_DIM)
        p = bi_token_shift(p, mu)
        r, k, v, xw, xa, xg = jnp.split(p, RWKV_SPLITS, axis=-1)
        kk = heads(k * k_k)
        kk = kk * lax.rsqrt(jnp.maximum(jnp.sum(jnp.square(kk.astype(jnp.float32)), -1, keepdims=True),
                                        1e-24)).astype(kk.dtype)
        tw = jnp.tanh(xw)
        dirs = []
        for d in range(2):
            w_log = -jax.nn.softplus(-(w0[d] + tw @ w2[d])) - 0.5
            decay = jnp.exp(-jnp.exp(w_log.astype(jnp.float32))).astype(p.dtype)
            a = jax.nn.sigmoid(a0[d] + xa @ a2[d])
            dirs.append((heads(decay), heads(k * (1.0 + (a - 1.0) * k_a)), -kk, kk * heads(a)))
        g = jax.nn.sigmoid(xg) @ g2
        bonus = jnp.sum(heads(r * k) * r_k, -1, keepdims=True) * heads(v)
        return heads(r), heads(v), g, bonus, dirs

    def finish(y, bonus, g):
        y = layer_norm(y, gn_g.reshape(RWKV_HEADS, HEAD_DIM), gn_b.reshape(RWKV_HEADS, HEAD_DIM), RWKV_GN_EPS)
        return (y + bonus).reshape(g.shape) * g

    rc, vc, gc, bc, dc = prep(p_ctx)
    rl, vl, gl, bl, dl = prep(p_lat)
    s0 = jnp.zeros((p_lat.shape[0], RWKV_HEADS, HEAD_DIM, HEAD_DIM), p_lat.dtype)
    y_ctx, y_lat = 0.0, 0.0
    for d, rev in enumerate((False, True)):
        dec_c, k_c, av_c, bv_c = dc[d]
        dec_l, k_l, av_l, bv_l = dl[d]
        yc, s_ctx = rwkv_scan(rc, dec_c, k_c, vc, av_c, bv_c, s0, rev, need_ctx)
        yl, _ = rwkv_scan(rl, dec_l, k_l, vl, av_l, bv_l, s_ctx, rev, True)
        y_lat = y_lat + yl
        if need_ctx:
            y_ctx = y_ctx + yc
    o_ctx = finish(y_ctx, bc, gc) if need_ctx else None
    return o_ctx, finish(y_lat, bl, gl)


def diff_attend(q, k, v, lam):
    s = jnp.einsum('bqhmd,bkhmd->bhmqk', q, k).astype(jnp.float32) * (HEAD_DIM ** -0.5)
    p = jax.nn.softmax(s, axis=-1)
    w = (p[:, :, 0] - lam * p[:, :, 1]).astype(v.dtype)
    return jnp.einsum('bhqk,bkhe->bqhe', w, v)


def diff_attn_mixer(p_ctx, p_lat, rows, cols, lq1, lk1, lq2, lk2, subln_g, lam_init, need_ctx):
    def split(p):
        b_, l_ = p.shape[:2]
        q, k, v = jnp.split(p, 3, axis=-1)
        return (q.reshape(b_, l_, DIFF_HEADS, 2, HEAD_DIM), k.reshape(b_, l_, DIFF_HEADS, 2, HEAD_DIM),
                v.reshape(b_, l_, DIFF_HEADS, 2 * HEAD_DIM))

    qc, kc, vc = split(p_ctx)
    ql, kl, vl = split(p_lat)
    ql = rope_2d(ql, rows, cols)
    kl = rope_2d(kl, rows, cols)
    lam = (jnp.exp(jnp.sum(lq1 * lk1).astype(jnp.float32)) - jnp.exp(jnp.sum(lq2 * lk2).astype(jnp.float32))
           + lam_init)
    k_all = jnp.concatenate([kc, kl], 1)
    v_all = jnp.concatenate([vc, vl], 1)
    b_, l_ = p_lat.shape[:2]
    nb = l_ // ATTN_BLOCK
    qb = jnp.moveaxis(ql.reshape(b_, nb, ATTN_BLOCK, DIFF_HEADS, 2, HEAD_DIM), 1, 0)
    ob = lax.map(lambda qq: diff_attend(qq, k_all, v_all, lam), qb)
    o_lat = jnp.moveaxis(ob, 0, 1).reshape(b_, l_, DIFF_HEADS, 2 * HEAD_DIM)

    def finish(o):
        return (rms_norm(o, subln_g) * (1.0 - lam_init)).reshape(o.shape[:2] + (GROUP_WIDTH,))

    o_ctx = finish(diff_attend(qc, kc, vc, lam)) if need_ctx else None
    return o_ctx, finish(o_lat)


def ssd_chunked(xdt, adt, bm, cm, init, with_y):
    b, l, h, p = xdt.shape
    g, n = bm.shape[2], bm.shape[3]
    nc, q, e = l // SSD_CHUNK, SSD_CHUNK, h // g
    dt = xdt.dtype
    x = xdt.reshape(b, nc, q, g, e, p)
    a = adt.astype(jnp.float32).reshape(b, nc, q, g, e).transpose(0, 1, 3, 4, 2)
    bc = bm.reshape(b, nc, q, g, n)
    cc = cm.reshape(b, nc, q, g, n)
    a_cs = jnp.cumsum(a, -1)
    decay_to_end = jnp.exp(a_cs[..., -1:] - a_cs).astype(dt)
    states = jnp.einsum('bcsgn,bcges,bcsgep->bcgepn', bc, decay_to_end, x)
    states = jnp.concatenate([init.reshape(b, g, e, p, n)[:, None], states], 1)
    a_chunks = jnp.pad(jnp.moveaxis(a_cs[..., -1], 1, -1), ((0, 0), (0, 0), (0, 0), (1, 0)))
    chunk_decay = jnp.exp(segsum(a_chunks)).astype(dt)
    new_states = jnp.einsum('bgezc,bcgepn->bzgepn', chunk_decay, states)
    final = new_states[:, -1].reshape(b, h, p, n)
    if not with_y:
        return None, final
    prev = new_states[:, :-1]
    lmat = jnp.exp(segsum(a)).astype(dt)
    cb = jnp.einsum('bclgn,bcsgn->bcgls', cc, bc)
    y_diag = jnp.einsum('bcgls,bcgels,bcsgep->bclgep', cb, lmat, x)
    y_off = jnp.einsum('bclgn,bcgepn,bcgel->bclgep', cc, prev, jnp.exp(a_cs).astype(dt))
    return (y_diag + y_off).reshape(b, l, h, p), final


def flip_if(t, rev):
    return jnp.flip(t, 1) if rev else t


def ssd_mixer(p_ctx, p_lat, conv_w, conv_b, dt_bias, a_log, d_skip, norm_g, need_ctx):
    a_neg = -jnp.exp(a_log.astype(jnp.float32))

    def prep(p):
        b_, l_ = p.shape[:2]
        z, xbc, dt = jnp.split(p, [GROUP_WIDTH, GROUP_WIDTH + SSD_CONV_DIM], axis=-1)
        xbc = jax.nn.silu(dw_conv_centred(xbc, conv_w, conv_b))
        xs, bm, cm = jnp.split(xbc, [GROUP_WIDTH, GROUP_WIDTH + SSD_GROUPS * SSD_STATE], axis=-1)
        dt = jax.nn.softplus(dt.reshape(b_, l_, 2, SSD_HEADS) + dt_bias)
        return (z, xs.reshape(b_, l_, SSD_HEADS, HEAD_DIM), bm.reshape(b_, l_, SSD_GROUPS, SSD_STATE),
                cm.reshape(b_, l_, SSD_GROUPS, SSD_STATE), dt)

    zc, xc, bc, cc, dtc = prep(p_ctx)
    zl, xl, bl, cl, dtl = prep(p_lat)
    h0 = jnp.zeros((p_lat.shape[0], SSD_HEADS, HEAD_DIM, SSD_STATE), p_lat.dtype)
    y_ctx, y_lat = 0.0, 0.0
    for d, rev in enumerate((False, True)):
        yc, h_ctx = ssd_chunked(flip_if(xc * dtc[:, :, d, :, None], rev), flip_if(dtc[:, :, d] * a_neg[d], rev),
                                flip_if(bc, rev), flip_if(cc, rev), h0, need_ctx)
        yl, _ = ssd_chunked(flip_if(xl * dtl[:, :, d, :, None], rev), flip_if(dtl[:, :, d] * a_neg[d], rev),
                            flip_if(bl, rev), flip_if(cl, rev), h_ctx, True)
        y_lat = y_lat + flip_if(yl, rev)
        if need_ctx:
            y_ctx = y_ctx + flip_if(yc, rev)

    def finish(y, xs, z):
        y = (y + d_skip[:, None] * xs).reshape(z.shape) * jax.nn.silu(z)
        y = rms_norm(y.reshape(z.shape[:2] + (SSD_GROUPS, GROUP_WIDTH // SSD_GROUPS)),
                     norm_g.reshape(SSD_GROUPS, GROUP_WIDTH // SSD_GROUPS))
        return y.reshape(z.shape)

    o_ctx = finish(y_ctx, xc, zc) if need_ctx else None
    return o_ctx, finish(y_lat, xl, zl)


def sink_attend(q, k, v, mask, sink):
    s = jnp.einsum('bqhgd,bkhd->bhgqk', q, k).astype(jnp.float32) * (HEAD_DIM ** -0.5)
    s = jnp.where(mask, s, -jnp.inf)
    sink_col = jnp.broadcast_to(sink.astype(jnp.float32)[None, :, :, None, None], s.shape[:-1] + (1,))
    p = jax.nn.softmax(jnp.concatenate([sink_col, s], -1), axis=-1)[..., 1:]
    return jnp.einsum('bhgqk,bkhd->bqhgd', p.astype(v.dtype), v)


def swa_mixer(p_ctx, p_lat, rows, cols, sink, need_ctx):
    group = SWA_HEADS // SWA_KV_HEADS
    sink = sink.reshape(SWA_KV_HEADS, group)
    kv_w = SWA_KV_HEADS * HEAD_DIM

    def split(p):
        b_, l_ = p.shape[:2]
        q, k, v = jnp.split(p, [GROUP_WIDTH, GROUP_WIDTH + kv_w], axis=-1)
        return (q.reshape(b_, l_, SWA_KV_HEADS, group, HEAD_DIM), k.reshape(b_, l_, SWA_KV_HEADS, HEAD_DIM),
                v.reshape(b_, l_, SWA_KV_HEADS, HEAD_DIM))

    qc, kc, vc = split(p_ctx)
    ql, kl, vl = split(p_lat)
    ql = rope_2d(ql, rows, cols)
    kl = rope_2d(kl, rows, cols)
    b_, l_ = p_lat.shape[:2]
    n_ctx = kc.shape[1]
    nb = l_ // SWA_BLOCK
    span = SWA_BLOCK + 2 * SWA_WINDOW
    pad = ((0, 0), (SWA_WINDOW, SWA_WINDOW), (0, 0), (0, 0))
    kp, vp = jnp.pad(kl, pad), jnp.pad(vl, pad)
    ctx_mask = jnp.ones((SWA_BLOCK, n_ctx), bool)

    def block(args):
        i, qq = args
        start = i * SWA_BLOCK
        kw = lax.dynamic_slice_in_dim(kp, start, span, axis=1)
        vw = lax.dynamic_slice_in_dim(vp, start, span, axis=1)
        qpos = start + jnp.arange(SWA_BLOCK)
        kpos = start - SWA_WINDOW + jnp.arange(span)
        win = (jnp.abs(qpos[:, None] - kpos[None, :]) <= SWA_WINDOW) & ((kpos >= 0) & (kpos < l_))[None, :]
        return sink_attend(qq, jnp.concatenate([kc, kw], 1), jnp.concatenate([vc, vw], 1),
                           jnp.concatenate([ctx_mask, win], 1), sink)

    qb = jnp.moveaxis(ql.reshape(b_, nb, SWA_BLOCK, SWA_KV_HEADS, group, HEAD_DIM), 1, 0)
    ob = lax.map(block, (jnp.arange(nb), qb))
    o_lat = jnp.moveaxis(ob, 0, 1).reshape(b_, l_, GROUP_WIDTH)
    if need_ctx:
        o_ctx = sink_attend(qc, kc, vc, jnp.ones((n_ctx, n_ctx), bool), sink).reshape(b_, n_ctx, GROUP_WIDTH)
    else:
        o_ctx = None
    return o_ctx, o_lat


def ffn_sublayer(h, shift, scale, gate, w1, w2, ln_g, ln_b):
    f = jnp.square(jax.nn.relu(modulate(h, shift, scale) @ w1)) @ w2
    return layer_norm(DEEPNORM_ALPHA * h + gate * f, ln_g, ln_b)


def setup_inputs(seed: int = 0) -> dict:
    key = jax.random.key(seed)
    ks = iter(jax.random.split(key, 48))

    def nrm(shape, scale=1.0):
        return jax.random.normal(next(ks), shape, jnp.float32) * scale

    def unif(shape, lo, hi):
        return jax.random.uniform(next(ks), shape, jnp.float32, lo, hi)

    D, GW = D_MODEL, GROUP_WIDTH
    dt0 = jnp.exp(unif((N_CD, 2, SSD_HEADS), math.log(1e-3), math.log(1e-1)))
    return {
        'x': nrm((BATCH, SEQ, D)),
        'c': nrm((BATCH, D)),
        'ctx': nrm((BATCH, CTX_LEN, D)),
        'c_ctx': nrm((D,)),
        'mod_w': nrm((DEPTH, D, 6 * D), 0.5 * D ** -0.5),
        'mod_b': nrm((DEPTH, 6 * D), 0.02),
        'ln_mix_g': 1.0 + nrm((DEPTH, D), 0.02),
        'ln_mix_b': nrm((DEPTH, D), 0.02),
        'ln_ffn_g': 1.0 + nrm((DEPTH, D), 0.02),
        'ln_ffn_b': nrm((DEPTH, D), 0.02),
        'ffn_w1': nrm((DEPTH, D, FFN_HIDDEN), D ** -0.5),
        'ffn_w2': nrm((DEPTH, FFN_HIDDEN, D), DEEPNORM_BETA * FFN_HIDDEN ** -0.5),
        'w_out': nrm((DEPTH, MIX_WIDTH, D), DEEPNORM_BETA * MIX_WIDTH ** -0.5),
        'ab_w_in': nrm((N_AB, D, AB_COLS), D ** -0.5),
        'rwkv_mu': unif((N_AB, RWKV_COLS), 0.0, 1.0),
        'rwkv_w0': unif((N_AB, 2, GW), -5.0, 1.0),
        'rwkv_w2': nrm((N_AB, 2, RWKV_DECAY_LORA, GW), 0.1 * RWKV_DECAY_LORA ** -0.5),
        'rwkv_a0': nrm((N_AB, 2, GW), 0.5),
        'rwkv_a2': nrm((N_AB, 2, RWKV_ICLR_LORA, GW), 0.1 * RWKV_ICLR_LORA ** -0.5),
        'rwkv_g2': nrm((N_AB, RWKV_GATE_LORA, GW), RWKV_GATE_LORA ** -0.5),
        'rwkv_k_k': 0.85 + nrm((N_AB, GW), 0.05),
        'rwkv_k_a': 1.0 + nrm((N_AB, GW), 0.05),
        'rwkv_r_k': nrm((N_AB, RWKV_HEADS, HEAD_DIM), 0.1),
        'rwkv_gn_g': 1.0 + nrm((N_AB, GW), 0.02),
        'rwkv_gn_b': nrm((N_AB, GW), 0.02),
        'diff_lq1': nrm((N_AB, HEAD_DIM), 0.1),
        'diff_lk1': nrm((N_AB, HEAD_DIM), 0.1),
        'diff_lq2': nrm((N_AB, HEAD_DIM), 0.1),
        'diff_lk2': nrm((N_AB, HEAD_DIM), 0.1),
        'diff_subln_g': 1.0 + nrm((N_AB, 2 * HEAD_DIM), 0.02),
        'cd_w_in': nrm((N_CD, D, CD_COLS), D ** -0.5),
        'ssd_conv_w': nrm((N_CD, SSD_CONV, SSD_CONV_DIM), SSD_CONV ** -0.5),
        'ssd_conv_b': nrm((N_CD, SSD_CONV_DIM), 0.02),
        'ssd_dt_bias': dt0 + jnp.log(-jnp.expm1(-dt0)),
        'ssd_a_log': jnp.log(unif((N_CD, 2, SSD_HEADS), 1.0, 16.0)),
        'ssd_d': 1.0 + nrm((N_CD, SSD_HEADS), 0.1),
        'ssd_norm_g': 1.0 + nrm((N_CD, GW), 0.02),
        'swa_sink': nrm((N_CD, SWA_HEADS), 0.5),
    }


def reference(x, c, ctx, c_ctx, mod_w, mod_b, ln_mix_g, ln_mix_b, ln_ffn_g, ln_ffn_b, ffn_w1, ffn_w2, w_out,
              ab_w_in, rwkv_mu, rwkv_w0, rwkv_w2, rwkv_a0, rwkv_a2, rwkv_g2, rwkv_k_k, rwkv_k_a, rwkv_r_k,
              rwkv_gn_g, rwkv_gn_b, diff_lq1, diff_lk1, diff_lq2, diff_lk2, diff_subln_g,
              cd_w_in, ssd_conv_w, ssd_conv_b, ssd_dt_bias, ssd_a_log, ssd_d, ssd_norm_g, swa_sink):
    n_lat = x.shape[1]
    n_rows = n_lat // GRID_W
    rows = jnp.repeat(jnp.arange(n_rows, dtype=jnp.int32), GRID_W)
    cols = jnp.tile(jnp.arange(GRID_W, dtype=jnp.int32), n_rows)
    silu_c = jax.nn.silu(c)
    silu_cc = jax.nn.silu(c_ctx)
    h_lat, h_ctx = x, ctx
    for i in range(DEPTH):
        need_ctx = i < DEPTH - 1
        m_lat = jnp.split((silu_c @ mod_w[i] + mod_b[i])[:, None, :], 6, axis=-1)
        m_ctx = jnp.split((silu_cc @ mod_w[i] + mod_b[i])[None, None, :], 6, axis=-1)
        j = i // 2
        w_in = ab_w_in[j] if i % 2 == 0 else cd_w_in[j]
        p_lat = modulate(h_lat, m_lat[0], m_lat[1]) @ w_in
        p_ctx = modulate(h_ctx, m_ctx[0], m_ctx[1]) @ w_in
        if i % 2 == 0:
            o1_ctx, o1_lat = rwkv7_mixer(p_ctx[..., :RWKV_COLS], p_lat[..., :RWKV_COLS], rwkv_mu[j], rwkv_w0[j],
                                         rwkv_w2[j], rwkv_a0[j], rwkv_a2[j], rwkv_g2[j], rwkv_k_k[j], rwkv_k_a[j],
                                         rwkv_r_k[j], rwkv_gn_g[j], rwkv_gn_b[j], need_ctx)
            o2_ctx, o2_lat = diff_attn_mixer(p_ctx[..., RWKV_COLS:], p_lat[..., RWKV_COLS:], rows, cols,
                                             diff_lq1[j], diff_lk1[j], diff_lq2[j], diff_lk2[j], diff_subln_g[j],
                                             0.8 - 0.6 * math.exp(-0.3 * i), need_ctx)
        else:
            o1_ctx, o1_lat = ssd_mixer(p_ctx[..., :SSD_COLS], p_lat[..., :SSD_COLS], ssd_conv_w[j], ssd_conv_b[j],
                                       ssd_dt_bias[j], ssd_a_log[j], ssd_d[j], ssd_norm_g[j], need_ctx)
            o2_ctx, o2_lat = swa_mixer(p_ctx[..., SSD_COLS:], p_lat[..., SSD_COLS:], rows, cols, swa_sink[j], need_ctx)
        o_lat = jnp.concatenate([o1_lat, o2_lat], -1) @ w_out[i]
        h_lat = layer_norm(DEEPNORM_ALPHA * h_lat + m_lat[2] * o_lat, ln_mix_g[i], ln_mix_b[i])
        h_lat = ffn_sublayer(h_lat, m_lat[3], m_lat[4], m_lat[5], ffn_w1[i], ffn_w2[i], ln_ffn_g[i], ln_ffn_b[i])
        if need_ctx:
            o_ctx = jnp.concatenate([o1_ctx, o2_ctx], -1) @ w_out[i]
            h_ctx = layer_norm(DEEPNORM_ALPHA * h_ctx + m_ctx[2] * o_ctx, ln_mix_g[i], ln_mix_b[i])
            h_ctx = ffn_sublayer(h_ctx, m_ctx[3], m_ctx[4], m_ctx[5], ffn_w1[i], ffn_w2[i], ln_ffn_g[i], ln_ffn_b[i])
    return h_lat
```

```cpp
#include <hip/hip_runtime.h>
#include <hip/hip_cooperative_groups.h>
#include <cstdio>
#include <cstdint>
namespace cg = cooperative_groups;
namespace pg8 {
#define PG8_LAS __attribute__((address_space(3)))
typedef unsigned short bf16_t;
typedef short bf16x8 __attribute__((ext_vector_type(8)));
typedef float f32x4 __attribute__((ext_vector_type(4)));
typedef unsigned u32x4 __attribute__((ext_vector_type(4)));
constexpr int BM = 256, BK = 64, HALF = 128, HTB = HALF * BK * 2  , STAGE_BYTES = 8 * HTB, NXCD = 8, WGM = 8;

__host__ __device__ __forceinline__ int lds_byte(int r, int c) { const int st = (r >> 4) * 2 + (c >> 5), rr = r & 15, cc = c & 31, ob = rr * 64 + cc * 2; return st * 1024 + (ob ^ (((ob >> 9) & 1) << 5)); }
__host__ __device__ __forceinline__ void stage_rc(int b, int& R, int& C) { const int st = b / 1024, sb = b % 1024, swz = sb ^ (((sb >> 9) & 1) << 5); R = (st >> 1) * 16 + swz / 64; C = (st & 1) * 32 + (swz % 64) / 2; }
__host__ __device__ __forceinline__ int perm32(int rho) { const int n = rho >> 4, i = rho & 15; return 8 * (i >> 2) + 4 * n + (i & 3); }

struct Unit { int pm, pn; };
struct Gemm { const bf16_t* A; const bf16_t* Bt; int M, N, K; };

__device__ __forceinline__ unsigned cvt_pk_bf16(float lo, float hi) { unsigned r; asm volatile("v_cvt_pk_bf16_f32 %0, %1, %2" : "=v"(r) : "v"(lo), "v"(hi)); return r; }
template <class Epi, class Sched, bool STAMP = false>
__device__ __forceinline__ void gemm_phase(PG8_LAS unsigned char* lds, const Gemm g, const Sched& S, const Epi& E, unsigned long long* stamps) {
    const int tid = threadIdx.x, wid = __builtin_amdgcn_readfirstlane(tid >> 6), lane = tid & 63, wr = wid >> 2, wc = wid & 3, fr = lane & 15, fq = lane >> 4;
    const int K = g.K, nt = K / BK;
    int ts_lo = 0, ts_hi = 0, nts = 0; const unsigned long long rt_entry = STAMP ? (unsigned long long)wall_clock64() : 0ull;
#define PG8_STAMP() do { if (STAMP && wid == 0 && nts < 64) { const unsigned long long _c = (unsigned long long)clock64(); \
        ts_lo = (lane == nts) ? (int)(unsigned)_c : ts_lo; ts_hi = (lane == nts) ? (int)(unsigned)(_c >> 32) : ts_hi; ++nts; } } while (0)
    PG8_STAMP();
    unsigned voffA[2], voffB[2];
#pragma unroll
    for (int i = 0; i < 2; ++i) { int R, C; stage_rc(tid * 16 + i * 8192, R, C); const int Rb = Epi::PERM ? ((R & ~31) + perm32(R & 31)) : R;
        voffA[i] = (unsigned)(R * K + C) * 2u; voffB[i] = (unsigned)(Rb * K + C) * 2u; }
    const size_t kstep = (size_t)(BK * 2);
    const size_t hstep = (size_t)HALF * K * 2;
    const size_t tstep = 2 * hstep;
    const unsigned ldsw = (unsigned)wid * 1024u;
    const int aoff = lds_byte(wr * 64 + fr, fq * 8), boff = lds_byte(wc * 32 + fr, fq * 8);
#define PG8_SA(b, h) (((b) * 2 + (h)) * HTB)
#define PG8_SB(b, h) ((4 + (b) * 2 + (h)) * HTB)
#define PG8_STAGE(bufoff, gbase, voff) do { _Pragma("unroll") for (int _i = 0; _i < 2; ++_i) \
        __builtin_amdgcn_global_load_lds((const unsigned*)((const char*)(gbase) + (voff)[_i]), (PG8_LAS unsigned*)(lds + (bufoff) + ldsw + _i * 8192), 16, 0, 0); } while (0)
#define PG8_LDA(dst, b, h) do { _Pragma("unroll") for (int m = 0; m < 4; ++m) _Pragma("unroll") for (int k = 0; k < 2; ++k) dst[m][k] = *(const PG8_LAS bf16x8*)(lds + PG8_SA(b, h) + aoff + m * 2048 + k * 1024); } while (0)
#define PG8_LDB(dst, b, h) do { _Pragma("unroll") for (int n = 0; n < 2; ++n) _Pragma("unroll") for (int k = 0; k < 2; ++k) dst[n][k] = *(const PG8_LAS bf16x8*)(lds + PG8_SB(b, h) + boff + n * 2048 + k * 1024); } while (0)
#define PG8_MMA(ai, bj, At, Bt) do { __builtin_amdgcn_s_setprio(1); _Pragma("unroll") for (int m = 0; m < 4; ++m) _Pragma("unroll") for (int n = 0; n < 2; ++n) _Pragma("unroll") for (int k = 0; k < 2; ++k) \
        acc[ai][bj][m][n] = __builtin_amdgcn_mfma_f32_16x16x32_bf16(Bt[n][k], At[m][k], acc[ai][bj][m][n], 0, 0, 0); __builtin_amdgcn_s_setprio(0); } while (0)
#define PG8_WAIT_V(n) asm volatile("s_waitcnt vmcnt(" #n ")" ::: "memory")
#define PG8_WAIT_L(n) asm volatile("s_waitcnt lgkmcnt(" #n ")" ::: "memory")
#define PG8_BAR __builtin_amdgcn_s_barrier()
#define PG8_SCHED __builtin_amdgcn_sched_barrier(0)
    Unit cur, nxt; int ui = 0;
    if (!S.next(0, cur)) return;
    f32x4 acc[2][2][4][2];
#pragma unroll
    for (int a = 0; a < 2; ++a)
#pragma unroll
        for (int b = 0; b < 2; ++b)
#pragma unroll
            for (int m = 0; m < 4; ++m)
#pragma unroll
                for (int n = 0; n < 2; ++n) acc[a][b][m][n] = (f32x4){0.f, 0.f, 0.f, 0.f};
    bf16x8 At[4][2], B0[2][2], B1[2][2];
    const char* cA = (const char*)g.A + (size_t)cur.pm * tstep; const char* cB = (const char*)g.Bt + (size_t)cur.pn * tstep;
    S.a_ready(cur);
    PG8_STAGE(PG8_SB(0, 0), cB, voffB); PG8_STAGE(PG8_SA(0, 0), cA, voffA); PG8_STAGE(PG8_SB(0, 1), cB + hstep, voffB); PG8_STAGE(PG8_SA(0, 1), cA + hstep, voffA);
    if (wr == 1) PG8_BAR;
    PG8_WAIT_V(4); PG8_BAR;
    PG8_STAGE(PG8_SB(1, 0), cB + kstep, voffB); PG8_STAGE(PG8_SA(1, 0), cA + kstep, voffA); PG8_STAGE(PG8_SB(1, 1), cB + hstep + kstep, voffB);
    PG8_WAIT_V(6); PG8_BAR;
    PG8_STAMP();
    for (;;) {
        const bool has_next = S.next(ui + 1, nxt);
        const char* nA = has_next ? (const char*)g.A + (size_t)nxt.pm * tstep : cA; const char* nB = has_next ? (const char*)g.Bt + (size_t)nxt.pn * tstep : cB;
        for (int t = 0; t < nt; t += 2) {
            const bool last = (t == nt - 2);
            const char* a1 = cA + (size_t)(t + 1) * kstep;
            const char* a2 = last ? nA : cA + (size_t)(t + 2) * kstep; const char* b2 = last ? nB : cB + (size_t)(t + 2) * kstep;
            const char* a3 = a2 + kstep; const char* b3 = b2 + kstep;
            if (last && has_next) S.a_ready(nxt);
            PG8_LDB(B0, 0, 0); PG8_SCHED; PG8_LDA(At, 0, 0); PG8_STAGE(PG8_SA(1, 1), a1 + hstep, voffA);
            PG8_WAIT_L(8); PG8_BAR; PG8_WAIT_L(0); PG8_MMA(0, 0, At, B0); PG8_BAR; PG8_SCHED;
            PG8_LDB(B1, 0, 1); PG8_STAGE(PG8_SB(0, 0), b2, voffB);
            PG8_BAR; PG8_WAIT_L(0); PG8_MMA(0, 1, At, B1); PG8_BAR;
            PG8_LDA(At, 0, 1); PG8_STAGE(PG8_SA(0, 0), a2, voffA);
            PG8_BAR; PG8_WAIT_L(0); PG8_MMA(1, 0, At, B0); PG8_BAR; PG8_SCHED;
            PG8_STAGE(PG8_SB(0, 1), b2 + hstep, voffB);
            PG8_WAIT_V(6); PG8_BAR; PG8_MMA(1, 1, At, B1); PG8_BAR;
            PG8_LDB(B0, 1, 0); PG8_SCHED; PG8_LDA(At, 1, 0); PG8_STAGE(PG8_SA(0, 1), a2 + hstep, voffA);
            PG8_WAIT_L(8); PG8_BAR; PG8_WAIT_L(0); PG8_MMA(0, 0, At, B0); PG8_BAR; PG8_SCHED;
            PG8_LDB(B1, 1, 1); PG8_STAGE(PG8_SB(1, 0), b3, voffB);
            PG8_BAR; PG8_WAIT_L(0); PG8_MMA(0, 1, At, B1); PG8_BAR;
            PG8_LDA(At, 1, 1); PG8_STAGE(PG8_SA(1, 0), a3, voffA);
            PG8_BAR; PG8_WAIT_L(0); PG8_MMA(1, 0, At, B0); PG8_BAR; PG8_SCHED;
            PG8_STAGE(PG8_SB(1, 1), b3 + hstep, voffB);
            PG8_WAIT_V(6); PG8_BAR; PG8_MMA(1, 1, At, B1); PG8_BAR;
        }
        PG8_STAMP();
        if constexpr (!Epi::AFTER_DRAIN) { E(acc, cur, wr, wc, fr, fq); S.done(cur); }
        PG8_STAMP();
        if (!has_next) break;
#pragma unroll
        for (int a = 0; a < 2; ++a)
#pragma unroll
            for (int b = 0; b < 2; ++b)
#pragma unroll
                for (int m = 0; m < 4; ++m)
#pragma unroll
                    for (int n = 0; n < 2; ++n) acc[a][b][m][n] = (f32x4){0.f, 0.f, 0.f, 0.f};
        cur = nxt; cA = nA; cB = nB; ++ui;
    }
    PG8_WAIT_V(0);
    if (wr == 0) PG8_BAR;
    PG8_BAR;
    if constexpr (Epi::AFTER_DRAIN) { E.fused(acc, cur, wr, wc, fr, fq, lds, wid, lane); S.done(cur); }
    PG8_STAMP();
    if (STAMP && wid == 0) { stamps[lane] = lane < nts ? (((unsigned long long)(unsigned)ts_hi << 32) | (unsigned)ts_lo) : 0ull;
        if (lane == 62) stamps[62] = rt_entry; if (lane == 63) stamps[63] = (unsigned long long)wall_clock64(); }
#undef PG8_STAMP
#undef PG8_SA
#undef PG8_SB
#undef PG8_STAGE
#undef PG8_LDA
#undef PG8_LDB
#undef PG8_MMA
#undef PG8_WAIT_V
#undef PG8_WAIT_L
#undef PG8_BAR
#undef PG8_SCHED
}
}

using pg8::bf16_t; using pg8::bf16x8; using pg8::f32x4; using pg8::u32x4;
typedef float f32x16 __attribute__((ext_vector_type(16)));
typedef float f32x2 __attribute__((ext_vector_type(2)));
typedef __bf16 bf16v2 __attribute__((ext_vector_type(2)));
typedef short s16x4 __attribute__((ext_vector_type(4)));
typedef unsigned u32x2 __attribute__((ext_vector_type(2)));
#define DI __device__ __forceinline__
#define LAS __attribute__((address_space(3)))

constexpr int NB = 16, LSEQ = 2048, NCTX = 256, TT = 2304, MROWS = NB * TT, DM = 1024;
constexpr int LDP0 = 3328, LDP1 = 2560, NCD = 2320;
constexpr float ALPHA = 1.41421356237f;
constexpr float LOG2E = 1.4426950408889634f;
constexpr float C2 = 0.125f * LOG2E;
constexpr int LDS_BYTES = 131072;
constexpr int NPH = 19;

constexpr size_t WS_MOD = 0;
constexpr size_t WS_WAB = 1u << 20;
constexpr size_t WS_WCD = WS_WAB + (size_t)3328 * 1024 * 2;
constexpr size_t WS_WOUT = WS_WCD + (size_t)2560 * 1024 * 2;
constexpr size_t WS_W1 = WS_WOUT + (size_t)2 * 1024 * 1024 * 2;
constexpr size_t WS_W2 = WS_W1 + (size_t)2 * 4096 * 1024 * 2;
constexpr size_t WS_ABUF = WS_W2 + (size_t)2 * 4096 * 1024 * 2;
constexpr size_t WS_HCTX = WS_ABUF + (size_t)MROWS * 1024 * 2;
constexpr size_t WS_BIG = WS_HCTX + (size_t)4096 * 1024 * 4;
constexpr size_t BIG_P = 0;
constexpr size_t BIG_VT0 = (size_t)MROWS * 3328 * 2;
constexpr size_t BIG_Y0 = BIG_VT0 + (size_t)16 * 4 * 128 * 2304 * 2;
constexpr size_t BIG_END0 = BIG_Y0 + (size_t)2 * MROWS * 512 * 2;
constexpr size_t BIG_XBC = (size_t)MROWS * 2560 * 2;
constexpr size_t BIG_VT1 = BIG_XBC + (size_t)MROWS * 1024 * 2;
constexpr size_t BIG_Y1 = BIG_VT1 + (size_t)16 * 2 * 64 * 2304 * 2;
constexpr size_t BIG_END1 = BIG_Y1 + (size_t)2 * MROWS * 512 * 2;
constexpr size_t BIG_ENDU = (size_t)MROWS * 4096 * 2;
constexpr size_t BIG_MAX = BIG_END0 > BIG_ENDU ? (BIG_END0 > BIG_END1 ? BIG_END0 : BIG_END1) : (BIG_ENDU > BIG_END1 ? BIG_ENDU : BIG_END1);
constexpr size_t WS_NEED = WS_BIG + BIG_MAX;

struct Params {
    const float* in[38];
    float* out;
    unsigned char* ws;
    int ph_lo, ph_hi;
};
enum { I_X = 0, I_C, I_CTX, I_CCTX, I_MODW, I_MODB, I_LNMG, I_LNMB, I_LNFG, I_LNFB, I_W1, I_W2, I_WOUT, I_ABW, I_MU, I_RW0, I_RW2, I_RA0, I_RA2, I_RG2, I_RKK, I_RKA, I_RRK, I_GNG, I_GNB,
       I_LQ1, I_LK1, I_LQ2, I_LK2, I_SUBLN, I_CDW, I_CONVW, I_CONVB, I_DTB, I_ALOG, I_SSDD, I_NORMG, I_SINK };

DI float bf2f(bf16_t v) { return __uint_as_float(((unsigned)v) << 16); }
DI unsigned pk2(float a, float b) { f32x2 v = {a, b}; bf16v2 r = __builtin_convertvector(v, bf16v2); return __builtin_bit_cast(unsigned, r); }
DI bf16_t f2bf(float a) { return (bf16_t)(pk2(a, 0.f) & 0xffffu); }
DI float lo2f(unsigned u) { return __uint_as_float(u << 16); }
DI float hi2f(unsigned u) { return __uint_as_float(u & 0xffff0000u); }
DI float sigmoidf_(float x) { return 1.0f / (1.0f + __expf(-x)); }
DI float siluf_(float x) { return x * sigmoidf_(x); }
DI float softplusf_(float x) { return fmaxf(x, 0.f) + __logf(1.0f + __expf(-fabsf(x))); }
DI float tanhf_(float x) { const float e = __expf(2.0f * x); return 1.0f - 2.0f / (1.0f + e); }
DI float wave_sum(float v) {
#pragma unroll
    for (int o = 1; o < 64; o <<= 1) v += __shfl_xor(v, o);
    return v;
}
DI float dpp_x1(float v) { return __int_as_float(__builtin_amdgcn_update_dpp(0, __float_as_int(v), 0xB1, 0xF, 0xF, true)); }
DI float dpp_x2(float v) { return __int_as_float(__builtin_amdgcn_update_dpp(0, __float_as_int(v), 0x4E, 0xF, 0xF, true)); }
DI float dpp_hm(float v) { return __int_as_float(__builtin_amdgcn_update_dpp(0, __float_as_int(v), 0x141, 0xF, 0xF, true)); }
DI float reduce8(float v) { v += dpp_x1(v); v += dpp_x2(v); v += dpp_hm(v); return v; }
DI int crow(int r, int hi) { return (r & 3) + 8 * (r >> 2) + 4 * hi; }
#define MFMA32(a, b, c) __builtin_amdgcn_mfma_f32_32x32x16_bf16((a), (b), (c), 0, 0, 0)

DI float* hrow_ptr(const Params& P, int r) {
    const int b = r / TT, t = r - b * TT;
    return t < NCTX ? (float*)(P.ws + WS_HCTX) + ((size_t)b * NCTX + t) * DM : P.out + ((size_t)b * LSEQ + (t - NCTX)) * DM;
}
DI const float* h0row_ptr(const Params& P, int r) {
    const int b = r / TT, t = r - b * TT;
    return t < NCTX ? P.in[I_CTX] + ((size_t)b * NCTX + t) * DM : P.in[I_X] + ((size_t)b * LSEQ + (t - NCTX)) * DM;
}
DI const float* modrow_ptr(const Params& P, int layer, int r) {
    const int b = r / TT, t = r - b * TT;
    return (const float*)(P.ws + WS_MOD) + ((size_t)layer * 17 + (t < NCTX ? 16 : b)) * 6144;
}

struct MyOrder {
    int nM, nN, nwg, G, c, latonly;
    DI void init(int nM_, int nN_, int G_, int c_, int latonly_) { nM = nM_; nN = nN_; nwg = nM * nN; G = G_; c = c_; latonly = latonly_; }
    DI bool next(int i, pg8::Unit& u) const {
        const long L = (long)i * G + c; if (L >= nwg) return false;
        int wgid = (int)L; { const int q = nwg / pg8::NXCD, r = nwg % pg8::NXCD, xcd = wgid % pg8::NXCD, off = wgid / pg8::NXCD; wgid = (xcd < r ? xcd * (q + 1) : r * (q + 1) + (xcd - r) * q) + off; }
        const int nig = pg8::WGM * nN, gid = wgid / nig, fm = gid * pg8::WGM, gsz = (nM - fm) < pg8::WGM ? (nM - fm) : pg8::WGM;
        int pm = fm + ((wgid % nig) % gsz); u.pn = (wgid % nig) / gsz;
        if (latonly) pm = (pm >> 3) * 9 + 1 + (pm & 7);
        u.pm = pm; return true;
    }
    DI void a_ready(const pg8::Unit&) const {}
    DI void done(const pg8::Unit&) const {}
};
template <int ACT> struct EpiB16 {
    static constexpr bool PERM = true, AFTER_DRAIN = false;
    bf16_t* O; int ldc;
    DI void operator()(const f32x4 (&acc)[2][2][4][2], const pg8::Unit& u, int wr, int wc, int fr, int fq) const {
        const int row0 = u.pm * 256 + wr * 64 + fr, col0 = u.pn * 256 + wc * 32 + 8 * fq;
#pragma unroll
        for (int ai = 0; ai < 2; ++ai)
#pragma unroll
            for (int m = 0; m < 4; ++m) { bf16_t* rowp = O + (size_t)(row0 + ai * 128 + m * 16) * ldc + col0;
#pragma unroll
                for (int bj = 0; bj < 2; ++bj) { f32x4 v0 = acc[ai][bj][m][0], v1 = acc[ai][bj][m][1];
                    if (ACT == 1) {
#pragma unroll
                        for (int j = 0; j < 4; ++j) { const float a = fmaxf(v0[j], 0.f), b = fmaxf(v1[j], 0.f); v0[j] = a * a; v1[j] = b * b; } }
                    u32x4 w; w.x = pk2(v0[0], v0[1]); w.y = pk2(v0[2], v0[3]); w.z = pk2(v1[0], v1[1]); w.w = pk2(v1[2], v1[3]);
                    *(u32x4*)(rowp + bj * 128) = w; } }
    }
};
struct EpiResid {
    static constexpr bool PERM = false, AFTER_DRAIN = false;
    const float* xin; const float* ctxin; float* hlat; float* hctx; const float* modv; int gate_off; int layer0;
    DI void operator()(const f32x4 (&acc)[2][2][4][2], const pg8::Unit& u, int wr, int wc, int fr, int fq) const {
        const int b = u.pm / 9, j = u.pm - 9 * b;
        const float* src; float* dst; const float* gate;
        if (j == 0) { const size_t o = (size_t)b * NCTX * DM; dst = hctx + o; src = layer0 ? ctxin + o : dst; gate = modv + 16 * 6144 + gate_off; }
        else { const size_t o = ((size_t)b * LSEQ + (size_t)(j - 1) * 256) * DM; dst = hlat + o; src = layer0 ? xin + o : dst; gate = modv + b * 6144 + gate_off; }
        const int rloc = wr * 64 + fr, col0 = u.pn * 256 + wc * 32 + 4 * fq;
#pragma unroll
        for (int ai = 0; ai < 2; ++ai)
#pragma unroll
            for (int m = 0; m < 4; ++m) { const size_t ro = (size_t)(rloc + ai * 128 + m * 16) * DM + col0;
#pragma unroll
                for (int bj = 0; bj < 2; ++bj)
#pragma unroll
                    for (int n = 0; n < 2; ++n) { const size_t o = ro + bj * 128 + n * 16; const f32x4 hv = *(const f32x4*)(src + o); const f32x4 gv = *(const f32x4*)(gate + col0 + bj * 128 + n * 16);
                        *(f32x4*)(dst + o) = hv * ALPHA + gv * acc[ai][bj][m][n]; }
                asm volatile("" ::: "memory"); }
    }
};

DI void transpose_item(const float* W, int K, int N, bf16_t* WT, int item, float* scr  ) {
    const int tid = threadIdx.x; const int nblk_k = K / 64; const int nb = item / nblk_k, kb = item - nb * nblk_k; const int k0 = kb * 64, n0 = nb * 64;
    __syncthreads();
#pragma unroll
    for (int p = 0; p < 8; ++p) { const int kk = p * 8 + (tid >> 6), n = tid & 63; scr[kk * 65 + n] = (n0 + n < N) ? W[(size_t)(k0 + kk) * N + n0 + n] : 0.f; }
    __syncthreads();
    { const int n = tid >> 3, kc = tid & 7; const float* s = scr + (kc * 8) * 65 + n;
      u32x4 o; o.x = pk2(s[0], s[65]); o.y = pk2(s[2 * 65], s[3 * 65]); o.z = pk2(s[4 * 65], s[5 * 65]); o.w = pk2(s[6 * 65], s[7 * 65]);
      *(u32x4*)(WT + (size_t)(n0 + n) * K + k0 + kc * 8) = o; }
}
DI void phase_prep(const Params& P, unsigned char* lds) {
    const int tid = threadIdx.x; float* scr = (float*)lds;
    constexpr int IT_AB = 16 * 52, IT_CD = 16 * 40, IT_WO = 16 * 16, IT_W1 = 16 * 64, IT_W2 = 64 * 16;
    constexpr int IT_ALL = IT_AB + IT_CD + 2 * IT_WO + 2 * IT_W1 + 2 * IT_W2;
    for (int it = blockIdx.x; it < IT_ALL; it += gridDim.x) {
        int r = it;
        if (r < IT_AB) { transpose_item(P.in[I_ABW], 1024, 3328, (bf16_t*)(P.ws + WS_WAB), r, scr); continue; } r -= IT_AB;
        if (r < IT_CD) { transpose_item(P.in[I_CDW], 1024, NCD, (bf16_t*)(P.ws + WS_WCD), r, scr); continue; } r -= IT_CD;
        if (r < 2 * IT_WO) { const int l = r / IT_WO; transpose_item(P.in[I_WOUT] + (size_t)l * 1024 * 1024, 1024, 1024, (bf16_t*)(P.ws + WS_WOUT) + (size_t)l * 1024 * 1024, r - l * IT_WO, scr); continue; } r -= 2 * IT_WO;
        if (r < 2 * IT_W1) { const int l = r / IT_W1; transpose_item(P.in[I_W1] + (size_t)l * 1024 * 4096, 1024, 4096, (bf16_t*)(P.ws + WS_W1) + (size_t)l * 1024 * 4096, r - l * IT_W1, scr); continue; } r -= 2 * IT_W1;
        { const int l = r / IT_W2; transpose_item(P.in[I_W2] + (size_t)l * 1024 * 4096, 4096, 1024, (bf16_t*)(P.ws + WS_W2) + (size_t)l * 1024 * 4096, r - l * IT_W2, scr); }
    }
    float* sc = (float*)lds;
    float* red = sc + 17 * 1024;
    bool staged = false;
    for (int it = blockIdx.x; it < 192; it += gridDim.x) {
        __syncthreads();
        if (!staged) { for (int e = tid; e < 17 * 1024; e += 512) { const int r = e >> 10, k = e & 1023; const float v = r < 16 ? P.in[I_C][r * 1024 + k] : P.in[I_CCTX][k]; sc[e] = siluf_(v); } staged = true; __syncthreads(); }
        const int layer = it / 96, col0 = (it - layer * 96) * 64; const int cgp = tid & 63, ks = tid >> 6;
        const float* W = P.in[I_MODW] + (size_t)layer * 1024 * 6144 + col0 + cgp;
        float acc[17];
#pragma unroll
        for (int r = 0; r < 17; ++r) acc[r] = 0.f;
        for (int k = ks * 128; k < ks * 128 + 128; ++k) { const float w = W[(size_t)k * 6144];
#pragma unroll
            for (int r = 0; r < 17; ++r) acc[r] += sc[r * 1024 + k] * w; }
#pragma unroll
        for (int r = 0; r < 17; ++r) red[(ks * 17 + r) * 64 + cgp] = acc[r];
        __syncthreads();
        for (int e = tid; e < 17 * 64; e += 512) { const int r = e >> 6, cc = e & 63; float s = P.in[I_MODB][layer * 6144 + col0 + cc];
#pragma unroll
            for (int q = 0; q < 8; ++q) s += red[(q * 17 + r) * 64 + cc];
            ((float*)(P.ws + WS_MOD))[((size_t)layer * 17 + r) * 6144 + col0 + cc] = s; }
    }
}

template <int MODE>
DI void phase_rows(const Params& P, int layer_ln, int ln_g_idx, int ln_b_idx, int layer_mod, int mod_off, bool latonly) {
    const int lane = threadIdx.x & 63, gw = blockIdx.x * 8 + (threadIdx.x >> 6), ngw = gridDim.x * 8;
    for (int r = gw; r < MROWS; r += ngw) {
        const int t = r % TT; if (latonly && t < NCTX) continue;
        f32x4 v[4];
        if (MODE == 0) { const f32x4* src = (const f32x4*)h0row_ptr(P, r) + lane;
#pragma unroll
            for (int j = 0; j < 4; ++j) v[j] = src[64 * j]; }
        else { f32x4* hp = (f32x4*)hrow_ptr(P, r) + lane; float s = 0.f;
#pragma unroll
            for (int j = 0; j < 4; ++j) { v[j] = hp[64 * j]; s += (v[j].x + v[j].y) + (v[j].z + v[j].w); }
            const float mean = wave_sum(s) * (1.f / 1024.f); float s2 = 0.f;
#pragma unroll
            for (int j = 0; j < 4; ++j) { v[j] = v[j] - mean; s2 += (v[j].x * v[j].x + v[j].y * v[j].y) + (v[j].z * v[j].z + v[j].w * v[j].w); }
            const float rstd = 1.0f / sqrtf(wave_sum(s2) * (1.f / 1024.f) + 1e-5f);
            const f32x4* g = (const f32x4*)(P.in[ln_g_idx] + layer_ln * 1024) + lane; const f32x4* bb = (const f32x4*)(P.in[ln_b_idx] + layer_ln * 1024) + lane;
#pragma unroll
            for (int j = 0; j < 4; ++j) { v[j] = v[j] * rstd * g[64 * j] + bb[64 * j]; hp[64 * j] = v[j]; } }
        if (MODE != 2) { const float* mv = modrow_ptr(P, layer_mod, r) + mod_off; const f32x4* sh = (const f32x4*)mv + lane; const f32x4* scl = (const f32x4*)(mv + 1024) + lane;
            u32x2* ap = (u32x2*)((bf16_t*)(P.ws + WS_ABUF) + (size_t)r * DM) + lane;
#pragma unroll
            for (int j = 0; j < 4; ++j) { const f32x4 o = v[j] * (scl[64 * j] + 1.0f) + sh[64 * j]; u32x2 w; w.x = pk2(o.x, o.y); w.y = pk2(o.z, o.w); ap[64 * j] = w; } }
    }
}

DI void phase_rope(bf16_t* Pb, int ldp, int col0, int nvec) {
    const long total = (long)NB * LSEQ * nvec * 16; const long stride = (long)gridDim.x * 512;
    for (long e = (long)blockIdx.x * 512 + threadIdx.x; e < total; e += stride) {
        const int j = (int)(e & 15); long q = e >> 4; const int vi = (int)(q % nvec); q /= nvec; const int i = (int)(q % LSEQ), b = (int)(q / LSEQ);
        bf16_t* p = Pb + (size_t)(b * TT + NCTX + i) * ldp + col0 + vi * 64 + j;
        const float inv = exp2f(-(float)j * (13.287712379549449f / 16.0f));
        const float ar = (float)(i >> 6) * inv, ac = (float)(i & 63) * inv;
        const float cr = __cosf(ar), sr = __sinf(ar), cc = __cosf(ac), sc = __sinf(ac);
        const float x0 = bf2f(p[0]), x1 = bf2f(p[16]), x2 = bf2f(p[32]), x3 = bf2f(p[48]);
        p[0] = f2bf(x0 * cr - x1 * sr); p[16] = f2bf(x1 * cr + x0 * sr); p[32] = f2bf(x2 * cc - x3 * sc); p[48] = f2bf(x3 * cc + x2 * sc);
    }
}
DI void phase_vt(const bf16_t* Pb, int ldp, int vcol0, int nh, int DV, bf16_t* Vt) {
    const long total = (long)NB * nh * (TT / 8) * DV; const long stride = (long)gridDim.x * 512;
    for (long e = (long)blockIdx.x * 512 + threadIdx.x; e < total; e += stride) {
        const int d = (int)(e % DV); long q = e / DV; const int kb = (int)(q % (TT / 8)); q /= (TT / 8); const int hh = (int)(q % nh), b = (int)(q / nh);
        const bf16_t* src = Pb + (size_t)(b * TT + kb * 8) * ldp + vcol0 + hh * DV + d;
        unsigned w[4];
#pragma unroll
        for (int i = 0; i < 4; ++i) w[i] = (unsigned)src[(size_t)(2 * i) * ldp] | ((unsigned)src[(size_t)(2 * i + 1) * ldp] << 16);
        u32x4 o; o.x = w[0]; o.y = w[1]; o.z = w[2]; o.w = w[3];
        *(u32x4*)(Vt + ((size_t)(b * nh + hh) * DV + d) * TT + kb * 8) = o;
    }
}
DI void phase_conv(const Params& P) {
    const bf16_t* Pb = (const bf16_t*)(P.ws + WS_BIG + BIG_P); bf16_t* X = (bf16_t*)(P.ws + WS_BIG + BIG_XBC);
    const long total = (long)MROWS * 128; const long stride = (long)gridDim.x * 512;
    for (long e = (long)blockIdx.x * 512 + threadIdx.x; e < total; e += stride) {
        const int c8 = (int)(e & 127) * 8; const int r = (int)(e >> 7); const int t = r % TT; const int lo = t < NCTX ? 0 : NCTX, hi = t < NCTX ? NCTX : TT;
        float acc[8];
        { const f32x4 b0 = *(const f32x4*)(P.in[I_CONVB] + c8), b1 = *(const f32x4*)(P.in[I_CONVB] + c8 + 4);
          acc[0] = b0.x; acc[1] = b0.y; acc[2] = b0.z; acc[3] = b0.w; acc[4] = b1.x; acc[5] = b1.y; acc[6] = b1.z; acc[7] = b1.w; }
#pragma unroll
        for (int k = 0; k < 5; ++k) { const int tq = t + k - 2; if (tq < lo || tq >= hi) continue;
            const u32x4 xv = *(const u32x4*)(Pb + (size_t)(r + k - 2) * LDP1 + 512 + c8);
            const f32x4 w0 = *(const f32x4*)(P.in[I_CONVW] + k * 1024 + c8), w1 = *(const f32x4*)(P.in[I_CONVW] + k * 1024 + c8 + 4);
            acc[0] += lo2f(xv.x) * w0.x; acc[1] += hi2f(xv.x) * w0.y; acc[2] += lo2f(xv.y) * w0.z; acc[3] += hi2f(xv.y) * w0.w;
            acc[4] += lo2f(xv.z) * w1.x; acc[5] += hi2f(xv.z) * w1.y; acc[6] += lo2f(xv.w) * w1.z; acc[7] += hi2f(xv.w) * w1.w; }
        u32x4 o; o.x = pk2(siluf_(acc[0]), siluf_(acc[1])); o.y = pk2(siluf_(acc[2]), siluf_(acc[3])); o.z = pk2(siluf_(acc[4]), siluf_(acc[5])); o.w = pk2(siluf_(acc[6]), siluf_(acc[7]));
        *(u32x4*)(X + (size_t)r * 1024 + c8) = o;
    }
}

template <int NMAP, int NDB, bool WIN>
DI void attn_tiles(f32x16 (&o)[NMAP][NDB], float (&mref)[NMAP], float (&lsum)[NMAP], const bf16x8 (&qf)[NMAP][4],
                   const bf16_t* Kb  , int ldk, const bf16_t* Vt  ,
                   int nkt, int r32, int hi, int qpos, int kpos0) {
    for (int kt = 0; kt < nkt; ++kt) {
        const bf16_t* kp = Kb + (size_t)(kt * 32 + r32) * ldk + hi * 8;
        const bf16_t* vp = Vt + (size_t)r32 * TT + kt * 32 + 4 * hi;
        bf16x8 pf[NMAP][2];
#pragma unroll
        for (int m = 0; m < NMAP; ++m) {
            bf16x8 kf[4];
#pragma unroll
            for (int s = 0; s < 4; ++s) kf[s] = *(const bf16x8*)(kp + m * 64 + s * 16);
            f32x16 st;
#pragma unroll
            for (int i = 0; i < 16; ++i) st[i] = 0.f;
#pragma unroll
            for (int s = 0; s < 4; ++s) st = MFMA32(kf[s], qf[m][s], st);
            if (WIN) {
#pragma unroll
                for (int i = 0; i < 16; ++i) { const int dlt = qpos - (kpos0 + kt * 32 + crow(i, hi)); if (dlt > 128 || dlt < -128) st[i] = -INFINITY; } }
            float mx = st[0];
#pragma unroll
            for (int i = 1; i < 16; ++i) mx = fmaxf(mx, st[i]);
            mx = fmaxf(mx, __shfl_xor(mx, 32));
            if (__any((mx - mref[m]) * C2 > 8.0f)) { const float nm = fmaxf(mref[m], mx); const float f = exp2f((mref[m] - nm) * C2); lsum[m] *= f; mref[m] = nm;
#pragma unroll
                for (int db = 0; db < NDB; ++db)
#pragma unroll
                    for (int i = 0; i < 16; ++i) o[m][db][i] *= f; }
            const float nmc = -mref[m] * C2; float ls = 0.f;
#pragma unroll
            for (int i = 0; i < 16; ++i) { st[i] = exp2f(st[i] * C2 + nmc); ls += st[i]; }
            lsum[m] += ls;
#pragma unroll
            for (int s = 0; s < 2; ++s) { u32x4 w; w.x = pk2(st[8 * s], st[8 * s + 1]); w.y = pk2(st[8 * s + 2], st[8 * s + 3]); w.z = pk2(st[8 * s + 4], st[8 * s + 5]); w.w = pk2(st[8 * s + 6], st[8 * s + 7]);
                pf[m][s] = __builtin_bit_cast(bf16x8, w); }
        }
#pragma unroll
        for (int db = 0; db < NDB; ++db) {
            bf16x8 vf[2];
#pragma unroll
            for (int s = 0; s < 2; ++s) { const s16x4 a = *(const s16x4*)(vp + (size_t)db * 32 * TT + 16 * s), b = *(const s16x4*)(vp + (size_t)db * 32 * TT + 16 * s + 8);
                vf[s] = __builtin_shufflevector(a, b, 0, 1, 2, 3, 4, 5, 6, 7); }
#pragma unroll
            for (int m = 0; m < NMAP; ++m)
#pragma unroll
                for (int s = 0; s < 2; ++s) o[m][db] = MFMA32(vf[s], pf[m][s], o[m][db]);
        }
    }
}
DI void diff_attn_wave(const Params& P, int b, int h, int qrow0, bool isctx, float lam, float lam_init) {
    const int lane = threadIdx.x & 63, r32 = lane & 31, hi = lane >> 5;
    const bf16_t* Pb = (const bf16_t*)(P.ws + WS_BIG + BIG_P);
    bf16x8 qf[2][4];
    { const bf16_t* qp = Pb + (size_t)(qrow0 + r32) * LDP0 + 1792 + h * 128 + hi * 8;
#pragma unroll
      for (int m = 0; m < 2; ++m)
#pragma unroll
          for (int s = 0; s < 4; ++s) qf[m][s] = *(const bf16x8*)(qp + m * 64 + s * 16); }
    f32x16 o[2][4]; float mref[2] = {-INFINITY, -INFINITY}, lsum[2] = {0.f, 0.f};
#pragma unroll
    for (int m = 0; m < 2; ++m)
#pragma unroll
        for (int db = 0; db < 4; ++db)
#pragma unroll
            for (int i = 0; i < 16; ++i) o[m][db][i] = 0.f;
    const bf16_t* Kb = Pb + (size_t)(b * TT) * LDP0 + 1792 + 512 + h * 128;
    const bf16_t* Vt = (const bf16_t*)(P.ws + WS_BIG + BIG_VT0) + (size_t)((b * 4 + h) * 128) * TT;
    attn_tiles<2, 4, false>(o, mref, lsum, qf, Kb, LDP0, Vt, isctx ? 8 : 72, r32, hi, 0, 0);
    const float l0 = lsum[0] + __shfl_xor(lsum[0], 32), l1 = lsum[1] + __shfl_xor(lsum[1], 32);
    const float i0 = 1.0f / l0, i1 = lam / l1; float ss = 0.f;
#pragma unroll
    for (int db = 0; db < 4; ++db)
#pragma unroll
        for (int i = 0; i < 16; ++i) { const float v = o[0][db][i] * i0 - o[1][db][i] * i1; o[0][db][i] = v; ss += v * v; }
    ss += __shfl_xor(ss, 32);
    const float rs = (1.0f / sqrtf(ss * (1.f / 128.f) + 1e-5f)) * (1.0f - lam_init);
    bf16_t* op = (bf16_t*)(P.ws + WS_ABUF) + (size_t)(qrow0 + r32) * DM + 512 + h * 128;
    const float* sg = P.in[I_SUBLN];
#pragma unroll
    for (int db = 0; db < 4; ++db)
#pragma unroll
        for (int g = 0; g < 4; ++g) { const int d = db * 32 + 8 * g + 4 * hi; const f32x4 gg = *(const f32x4*)(sg + d);
            u32x2 w; w.x = pk2(o[0][db][4 * g] * rs * gg.x, o[0][db][4 * g + 1] * rs * gg.y); w.y = pk2(o[0][db][4 * g + 2] * rs * gg.z, o[0][db][4 * g + 3] * rs * gg.w);
            *(u32x2*)(op + d) = w; }
}
DI void phase_diff_attn(const Params& P) {
    const int lane = threadIdx.x & 63, wave = threadIdx.x >> 6;
    float lam;
    { const float a = P.in[I_LQ1][lane] * P.in[I_LK1][lane], b2 = P.in[I_LQ2][lane] * P.in[I_LK2][lane]; lam = expf(wave_sum(a)) - expf(wave_sum(b2)) + 0.2f; }
    for (int it = blockIdx.x; it < 576; it += gridDim.x) {
        if (it < 512) { const int qb = it & 7, h = (it >> 3) & 3, b = it >> 5; diff_attn_wave(P, b, h, b * TT + NCTX + qb * 256 + wave * 32, false, lam, 0.2f); }
        else { const int e = it - 512; const int h = e & 3, b = e >> 2; diff_attn_wave(P, b, h, b * TT + wave * 32, true, lam, 0.2f); }
    }
}
DI void swa_wave(const Params& P, int b, int hq, int i0) {
    const int lane = threadIdx.x & 63, r32 = lane & 31, hi = lane >> 5; const int kvh = hq >> 2;
    const bf16_t* Pb = (const bf16_t*)(P.ws + WS_BIG + BIG_P);
    const int qrow0 = b * TT + NCTX + i0;
    bf16x8 qf[1][4];
    { const bf16_t* qp = Pb + (size_t)(qrow0 + r32) * LDP1 + 1552 + hq * 64 + hi * 8;
#pragma unroll
      for (int s = 0; s < 4; ++s) qf[0][s] = *(const bf16x8*)(qp + s * 16); }
    f32x16 o[1][2]; float mref[1] = {-INFINITY}, lsum[1] = {0.f};
#pragma unroll
    for (int db = 0; db < 2; ++db)
#pragma unroll
        for (int i = 0; i < 16; ++i) o[0][db][i] = 0.f;
    const bf16_t* Kb = Pb + (size_t)(b * TT) * LDP1 + 1552 + 512 + kvh * 64;
    const bf16_t* Vt = (const bf16_t*)(P.ws + WS_BIG + BIG_VT1) + (size_t)((b * 2 + kvh) * 64) * TT;
    attn_tiles<1, 2, false>(o, mref, lsum, qf, Kb, LDP1, Vt, 8, r32, hi, 0, 0);
    const int t0 = i0 >> 5; const int ktlo = t0 - 4 < 0 ? 0 : t0 - 4, kthi = t0 + 4 > 63 ? 63 : t0 + 4;
    attn_tiles<1, 2, true>(o, mref, lsum, qf, Kb + (size_t)(NCTX + ktlo * 32) * LDP1, LDP1, Vt + NCTX + ktlo * 32, kthi - ktlo + 1, r32, hi, i0 + r32, ktlo * 32);
    float l = lsum[0] + __shfl_xor(lsum[0], 32);
    l += exp2f(P.in[I_SINK][hq] * LOG2E - mref[0] * C2);
    const float il = 1.0f / l;
    bf16_t* op = (bf16_t*)(P.ws + WS_ABUF) + (size_t)(qrow0 + r32) * DM + 512 + hq * 64;
#pragma unroll
    for (int db = 0; db < 2; ++db)
#pragma unroll
        for (int g = 0; g < 4; ++g) { const int d = db * 32 + 8 * g + 4 * hi;
            u32x2 w; w.x = pk2(o[0][db][4 * g] * il, o[0][db][4 * g + 1] * il); w.y = pk2(o[0][db][4 * g + 2] * il, o[0][db][4 * g + 3] * il);
            *(u32x2*)(op + d) = w; }
}
DI void phase_swa(const Params& P) {
    const int wave = threadIdx.x >> 6;
    for (int it = blockIdx.x; it < 1024; it += gridDim.x) { const int qb = it & 7, hq = (it >> 3) & 7, b = it >> 6; swa_wave(P, b, hq, qb * 256 + wave * 32); }
}

DI void rwkv_chain(const Params& P, unsigned char* lds, int chain) {
    const int tid = threadIdx.x, lane = tid & 63, wave = tid >> 6;
    const int b = chain >> 4, h = (chain >> 1) & 7, d = chain & 1;
    const bf16_t* Pb = (const bf16_t*)(P.ws + WS_BIG + BIG_P);
    float* rs = (float*)lds;
    float* ks = rs + 2048; float* vs = ks + 2048; float* tw = vs + 2048; float* xa = tw + 2048;
    float* wd = xa + 2048; float* km = wd + 2048; float* kk = km + 2048; float* bv = kk + 2048;
    bf16_t* raw = (bf16_t*)wd;
    bf16_t* yb = (bf16_t*)(bv + 2048);
    float* w2s = (float*)(yb + 2048);
    float* a2s = w2s + 4096;
    bf16_t* yout = (bf16_t*)(P.ws + WS_BIG + BIG_Y0) + (size_t)d * MROWS * 512;
    const int hj = h * 64 + lane;
    __syncthreads();
    for (int e = tid; e < 4096; e += 512) { const int i = e >> 6, j = e & 63; w2s[e] = P.in[I_RW2][(size_t)(d * 64 + i) * 512 + h * 64 + j]; a2s[e] = P.in[I_RA2][(size_t)(d * 64 + i) * 512 + h * 64 + j]; }
    const float w0v = P.in[I_RW0][d * 512 + hj], a0v = P.in[I_RA0][d * 512 + hj], kkv = P.in[I_RKK][hj], kav = P.in[I_RKA][hj];
    float S[8];
#pragma unroll
    for (int j = 0; j < 8; ++j) S[j] = 0.f;
    const int vrow = wave * 8 + (lane >> 3), kc = (lane & 7) * 8;
    for (int c = 0; c < 72; ++c) {
        const int tlo = d == 0 ? 32 * c : (c < 8 ? 224 - 32 * c : 2528 - 32 * c);
        const int slo = tlo < NCTX ? 0 : NCTX, shi = tlo < NCTX ? NCTX : TT;
        for (int e = tid; e < 34 * 40; e += 512) { const int rr = e / 40, rem = e - rr * 40, g = rem >> 3, c8 = rem & 7; const int tq = tlo - 1 + rr;
            const int col = g < 3 ? g * 512 + h * 64 : (g == 3 ? 1536 : 1600);
            u32x4 v = {0u, 0u, 0u, 0u};
            if (tq >= slo && tq < shi) v = *(const u32x4*)(Pb + (size_t)(b * TT + tq) * LDP0 + col + c8 * 8);
            *(u32x4*)(raw + rr * 320 + g * 64 + c8 * 8) = v; }
        __syncthreads();
        { const int tt = tid >> 4, l16 = tid & 15;
#pragma unroll
          for (int i = 0; i < 20; ++i) { const int g = i >> 2, cc = l16 + 16 * (i & 3); const int col = g < 3 ? g * 512 + h * 64 : (g == 3 ? 1536 : 1600);
              const float cur = bf2f(raw[(tt + 1) * 320 + g * 64 + cc]), prv = bf2f(raw[tt * 320 + g * 64 + cc]), nxt = bf2f(raw[(tt + 2) * 320 + g * 64 + cc]);
              const float mu = P.in[I_MU][col + cc]; float s = cur + mu * (0.5f * (prv + nxt) - cur);
              float* dst = g == 0 ? rs : (g == 1 ? ks : (g == 2 ? vs : (g == 3 ? tw : xa)));
              if (g == 3) s = tanhf_(s);
              dst[tt * 64 + cc] = s; } }
        __syncthreads();
        { float wp[4], ap[4];
#pragma unroll
          for (int q = 0; q < 4; ++q) { wp[q] = w0v; ap[q] = a0v; }
#pragma unroll 2
          for (int i4 = 0; i4 < 16; ++i4) {
              const float wc0 = w2s[(i4 * 4) * 64 + lane], wc1 = w2s[(i4 * 4 + 1) * 64 + lane], wc2 = w2s[(i4 * 4 + 2) * 64 + lane], wc3 = w2s[(i4 * 4 + 3) * 64 + lane];
              const float ac0 = a2s[(i4 * 4) * 64 + lane], ac1 = a2s[(i4 * 4 + 1) * 64 + lane], ac2 = a2s[(i4 * 4 + 2) * 64 + lane], ac3 = a2s[(i4 * 4 + 3) * 64 + lane];
#pragma unroll
              for (int q = 0; q < 4; ++q) { const f32x4 t4 = *(const f32x4*)(tw + (wave * 4 + q) * 64 + i4 * 4), x4 = *(const f32x4*)(xa + (wave * 4 + q) * 64 + i4 * 4);
                  wp[q] += t4.x * wc0 + t4.y * wc1 + t4.z * wc2 + t4.w * wc3;
                  ap[q] += x4.x * ac0 + x4.y * ac1 + x4.z * ac2 + x4.w * ac3; } }
#pragma unroll
          for (int q = 0; q < 4; ++q) { const int tt = wave * 4 + q;
              const float wl = -softplusf_(-wp[q]) - 0.5f; const float dec = expf(-expf(wl)); const float a = sigmoidf_(ap[q]);
              const float kraw = ks[tt * 64 + lane]; const float kkr = kraw * kkv; const float ss = wave_sum(kkr * kkr); const float kkn = kkr * (1.0f / sqrtf(fmaxf(ss, 1e-24f)));
              wd[tt * 64 + lane] = dec; km[tt * 64 + lane] = kraw * (1.0f + (a - 1.0f) * kav); kk[tt * 64 + lane] = kkn; bv[tt * 64 + lane] = kkn * a; } }
        __syncthreads();
        for (int n = 0; n < 32; ++n) { const int tt = d ? 31 - n : n; const int o = tt * 64 + kc;
            const f32x4 w_0 = *(const f32x4*)(wd + o), w_1 = *(const f32x4*)(wd + o + 4), m_0 = *(const f32x4*)(km + o), m_1 = *(const f32x4*)(km + o + 4);
            const f32x4 k_0 = *(const f32x4*)(kk + o), k_1 = *(const f32x4*)(kk + o + 4), b_0 = *(const f32x4*)(bv + o), b_1 = *(const f32x4*)(bv + o + 4);
            const f32x4 r_0 = *(const f32x4*)(rs + o), r_1 = *(const f32x4*)(rs + o + 4); const float vv = vs[tt * 64 + vrow];
            float sa = (S[0] * k_0.x + S[1] * k_0.y) + (S[2] * k_0.z + S[3] * k_0.w) + (S[4] * k_1.x + S[5] * k_1.y) + (S[6] * k_1.z + S[7] * k_1.w);
            sa = -reduce8(sa);
            S[0] = S[0] * w_0.x + sa * b_0.x + vv * m_0.x; S[1] = S[1] * w_0.y + sa * b_0.y + vv * m_0.y; S[2] = S[2] * w_0.z + sa * b_0.z + vv * m_0.z; S[3] = S[3] * w_0.w + sa * b_0.w + vv * m_0.w;
            S[4] = S[4] * w_1.x + sa * b_1.x + vv * m_1.x; S[5] = S[5] * w_1.y + sa * b_1.y + vv * m_1.y; S[6] = S[6] * w_1.z + sa * b_1.z + vv * m_1.z; S[7] = S[7] * w_1.w + sa * b_1.w + vv * m_1.w;
            float y = (S[0] * r_0.x + S[1] * r_0.y) + (S[2] * r_0.z + S[3] * r_0.w) + (S[4] * r_1.x + S[5] * r_1.y) + (S[6] * r_1.z + S[7] * r_1.w);
            y = reduce8(y);
            if ((lane & 7) == 0) yb[tt * 64 + vrow] = f2bf(y); }
        __syncthreads();
        if (tid < 256) { const int tt = tid >> 3, c8 = tid & 7; *(u32x4*)(yout + (size_t)(b * TT + tlo + tt) * 512 + h * 64 + c8 * 8) = *(const u32x4*)(yb + tt * 64 + c8 * 8); }
    }
    __syncthreads();
}
DI void phase_rwkv_finish(const Params& P, unsigned char* lds) {
    const int tid = threadIdx.x, lane = tid & 63, h = tid >> 6;
    const bf16_t* Pb = (const bf16_t*)(P.ws + WS_BIG + BIG_P);
    const bf16_t* y0 = (const bf16_t*)(P.ws + WS_BIG + BIG_Y0); const bf16_t* y1 = y0 + (size_t)MROWS * 512;
    float* sg = (float*)lds;
    const float mur = P.in[I_MU][tid], muk = P.in[I_MU][512 + tid], muv = P.in[I_MU][1024 + tid];
    const float rk = P.in[I_RRK][tid], gng = P.in[I_GNG][tid], gnb = P.in[I_GNB][tid];
    for (int it = blockIdx.x; it < MROWS / 16; it += gridDim.x) {
        const int r0 = it * 16; const int t0 = r0 % TT; const int slo = t0 < NCTX ? 0 : NCTX, shi = t0 < NCTX ? NCTX : TT;
        __syncthreads();
        for (int e = tid; e < 16 * 128; e += 512) { const int tt = e >> 7, cc = e & 127; const int t = t0 + tt; const bf16_t* p = Pb + (size_t)(r0 + tt) * LDP0 + 1664 + cc;
            const float cur = bf2f(p[0]); const float prv = t - 1 >= slo ? bf2f(*(p - LDP0)) : 0.f; const float nxt = t + 1 < shi ? bf2f(p[LDP0]) : 0.f;
            const float mu = P.in[I_MU][1664 + cc]; sg[e] = sigmoidf_(cur + mu * (0.5f * (prv + nxt) - cur)); }
        __syncthreads();
        float g[16];
#pragma unroll
        for (int tt = 0; tt < 16; ++tt) g[tt] = 0.f;
        for (int i = 0; i < 128; i += 4) { const float g0 = P.in[I_RG2][(size_t)i * 512 + tid], g1 = P.in[I_RG2][(size_t)(i + 1) * 512 + tid], g2 = P.in[I_RG2][(size_t)(i + 2) * 512 + tid], g3 = P.in[I_RG2][(size_t)(i + 3) * 512 + tid];
#pragma unroll
            for (int tt = 0; tt < 16; ++tt) { const f32x4 s4 = *(const f32x4*)(sg + tt * 128 + i); g[tt] += s4.x * g0 + s4.y * g1 + s4.z * g2 + s4.w * g3; } }
#pragma unroll
        for (int tt = 0; tt < 16; ++tt) { const int r = r0 + tt, t = t0 + tt; const bf16_t* p = Pb + (size_t)r * LDP0 + tid;
            const bool hp = t - 1 >= slo, hn = t + 1 < shi;
            const float rc = bf2f(p[0]), kc_ = bf2f(p[512]), vc = bf2f(p[1024]);
            const float rp = hp ? bf2f(*(p - LDP0)) : 0.f, kp = hp ? bf2f(*(p - LDP0 + 512)) : 0.f, vp = hp ? bf2f(*(p - LDP0 + 1024)) : 0.f;
            const float rn = hn ? bf2f(p[LDP0]) : 0.f, kn = hn ? bf2f(p[LDP0 + 512]) : 0.f, vn = hn ? bf2f(p[LDP0 + 1024]) : 0.f;
            const float r_s = rc + mur * (0.5f * (rp + rn) - rc), k_s = kc_ + muk * (0.5f * (kp + kn) - kc_), v_s = vc + muv * (0.5f * (vp + vn) - vc);
            const float bonus = wave_sum(r_s * k_s * rk) * v_s;
            const float y = bf2f(y0[(size_t)r * 512 + tid]) + bf2f(y1[(size_t)r * 512 + tid]);
            const float mean = wave_sum(y) * (1.f / 64.f); const float dy = y - mean; const float var = wave_sum(dy * dy) * (1.f / 64.f);
            const float yn = dy * (1.0f / sqrtf(var + 64e-5f)) * gng + gnb;
            ((bf16_t*)(P.ws + WS_ABUF))[(size_t)r * DM + tid] = f2bf((yn + bonus) * g[tt]); }
    }
}

DI void ssd_chain(const Params& P, unsigned char* lds, int chain) {
    const int tid = threadIdx.x, lane = tid & 63, wave = tid >> 6;
    const int b = chain >> 4, h = (chain >> 1) & 7, d = chain & 1, g = h >> 2;
    const bf16_t* Pb = (const bf16_t*)(P.ws + WS_BIG + BIG_P); const bf16_t* X = (const bf16_t*)(P.ws + WS_BIG + BIG_XBC);
    bf16_t* yout = (bf16_t*)(P.ws + WS_BIG + BIG_Y1) + (size_t)d * MROWS * 512;
    float* xs = (float*)lds;
    float* Bs = xs + 2048;
    float* Cs = Bs + 4096;
    float* dts = Cs + 4096;
    float* das = dts + 32;
    bf16_t* yb = (bf16_t*)(das + 32);
    const float dtb = P.in[I_DTB][d * 8 + h], aneg = -expf(P.in[I_ALOG][d * 8 + h]);
    float hs[16];
#pragma unroll
    for (int j = 0; j < 16; ++j) hs[j] = 0.f;
    const int prow = wave * 8 + (lane >> 3), nc = (lane & 7) * 16;
    for (int c = 0; c < 72; ++c) {
        const int tlo = d == 0 ? 32 * c : (c < 8 ? 224 - 32 * c : 2528 - 32 * c);
        for (int e = tid; e < 32 * 40; e += 512) { const int tt = e / 40, rem = e - tt * 40; const size_t r = (size_t)(b * TT + tlo + tt);
            int col; float* dst;
            if (rem < 8) { col = h * 64 + rem * 8; dst = xs + tt * 64 + rem * 8; }
            else if (rem < 24) { col = 512 + g * 128 + (rem - 8) * 8; dst = Bs + tt * 128 + (rem - 8) * 8; }
            else { col = 768 + g * 128 + (rem - 24) * 8; dst = Cs + tt * 128 + (rem - 24) * 8; }
            const u32x4 v = *(const u32x4*)(X + r * 1024 + col);
            *(f32x4*)dst = (f32x4){lo2f(v.x), hi2f(v.x), lo2f(v.y), hi2f(v.y)}; *(f32x4*)(dst + 4) = (f32x4){lo2f(v.z), hi2f(v.z), lo2f(v.w), hi2f(v.w)}; }
        if (tid < 32) { const float raw = bf2f(Pb[(size_t)(b * TT + tlo + tid) * LDP1 + 1536 + d * 8 + h]); const float dt = softplusf_(raw + dtb); dts[tid] = dt; das[tid] = expf(dt * aneg); }
        __syncthreads();
        for (int n = 0; n < 32; ++n) { const int tt = d ? 31 - n : n;
            const float da = das[tt], xv = xs[tt * 64 + prow] * dts[tt]; const float* bp = Bs + tt * 128 + nc; const float* cp = Cs + tt * 128 + nc;
            float y = 0.f;
#pragma unroll
            for (int q = 0; q < 4; ++q) { const f32x4 b4 = *(const f32x4*)(bp + 4 * q), c4 = *(const f32x4*)(cp + 4 * q);
                hs[4 * q] = hs[4 * q] * da + xv * b4.x; hs[4 * q + 1] = hs[4 * q + 1] * da + xv * b4.y; hs[4 * q + 2] = hs[4 * q + 2] * da + xv * b4.z; hs[4 * q + 3] = hs[4 * q + 3] * da + xv * b4.w;
                y += (hs[4 * q] * c4.x + hs[4 * q + 1] * c4.y) + (hs[4 * q + 2] * c4.z + hs[4 * q + 3] * c4.w); }
            y = reduce8(y);
            if ((lane & 7) == 0) yb[tt * 64 + prow] = f2bf(y); }
        __syncthreads();
        if (tid < 256) { const int tt = tid >> 3, c8 = tid & 7; *(u32x4*)(yout + (size_t)(b * TT + tlo + tt) * 512 + h * 64 + c8 * 8) = *(const u32x4*)(yb + tt * 64 + c8 * 8); }
        __syncthreads();
    }
}
DI void phase_ssd_finish(const Params& P) {
    const int lane = threadIdx.x & 63, gw = blockIdx.x * 8 + (threadIdx.x >> 6), ngw = gridDim.x * 8;
    const bf16_t* Pb = (const bf16_t*)(P.ws + WS_BIG + BIG_P); const bf16_t* X = (const bf16_t*)(P.ws + WS_BIG + BIG_XBC);
    const bf16_t* y0 = (const bf16_t*)(P.ws + WS_BIG + BIG_Y1); const bf16_t* y1 = y0 + (size_t)MROWS * 512;
    const int c8 = lane * 8; const float dsk = P.in[I_SSDD][lane >> 3];
    for (int r = gw; r < MROWS; r += ngw) { if (r % TT < NCTX) continue;
        const u32x4 zv = *(const u32x4*)(Pb + (size_t)r * LDP1 + c8), xv = *(const u32x4*)(X + (size_t)r * 1024 + c8), av = *(const u32x4*)(y0 + (size_t)r * 512 + c8), bv = *(const u32x4*)(y1 + (size_t)r * 512 + c8);
        float z[8] = {lo2f(zv.x), hi2f(zv.x), lo2f(zv.y), hi2f(zv.y), lo2f(zv.z), hi2f(zv.z), lo2f(zv.w), hi2f(zv.w)};
        float x[8] = {lo2f(xv.x), hi2f(xv.x), lo2f(xv.y), hi2f(xv.y), lo2f(xv.z), hi2f(xv.z), lo2f(xv.w), hi2f(xv.w)};
        float ya[8] = {lo2f(av.x), hi2f(av.x), lo2f(av.y), hi2f(av.y), lo2f(av.z), hi2f(av.z), lo2f(av.w), hi2f(av.w)};
        float yb_[8] = {lo2f(bv.x), hi2f(bv.x), lo2f(bv.y), hi2f(bv.y), lo2f(bv.z), hi2f(bv.z), lo2f(bv.w), hi2f(bv.w)};
        float v[8]; float ss = 0.f;
#pragma unroll
        for (int j = 0; j < 8; ++j) { v[j] = (ya[j] + yb_[j] + dsk * x[j]) * siluf_(z[j]); ss += v[j] * v[j]; }
#pragma unroll
        for (int o = 1; o < 32; o <<= 1) ss += __shfl_xor(ss, o);
        const float rs = 1.0f / sqrtf(ss * (1.f / 256.f) + 1e-5f);
        const f32x4 g0 = *(const f32x4*)(P.in[I_NORMG] + c8), g1 = *(const f32x4*)(P.in[I_NORMG] + c8 + 4);
        u32x4 o; o.x = pk2(v[0] * rs * g0.x, v[1] * rs * g0.y); o.y = pk2(v[2] * rs * g0.z, v[3] * rs * g0.w); o.z = pk2(v[4] * rs * g1.x, v[5] * rs * g1.y); o.w = pk2(v[6] * rs * g1.z, v[7] * rs * g1.w);
        *(u32x4*)((bf16_t*)(P.ws + WS_ABUF) + (size_t)r * DM + c8) = o; }
}

template <class Epi>
DI void run_gemm(unsigned char* lds, const bf16_t* A, const bf16_t* Bt, int N, int K, bool latonly, const Epi& E) {
    MyOrder S; S.init(latonly ? 128 : 144, N / 256, gridDim.x, blockIdx.x, latonly ? 1 : 0);
    pg8::Gemm g; g.A = A; g.Bt = Bt; g.M = MROWS; g.N = N; g.K = K;
    pg8::gemm_phase<Epi, MyOrder, false>((PG8_LAS unsigned char*)lds, g, S, E, nullptr);
}
DI EpiResid make_resid(const Params& P, int layer, int gate_off, int layer0) {
    EpiResid e; e.xin = P.in[I_X]; e.ctxin = P.in[I_CTX]; e.hlat = P.out; e.hctx = (float*)(P.ws + WS_HCTX); e.modv = (const float*)(P.ws + WS_MOD) + (size_t)layer * 17 * 6144; e.gate_off = gate_off; e.layer0 = layer0; return e;
}

__global__ void __launch_bounds__(512) mega(Params P) {
    extern __shared__ __attribute__((aligned(16))) unsigned char lds[];
    cg::grid_group grid = cg::this_grid();
    bf16_t* ABUF = (bf16_t*)(P.ws + WS_ABUF); bf16_t* PB = (bf16_t*)(P.ws + WS_BIG + BIG_P);
#define PHASE(k) if (P.ph_lo <= (k) && (k) < P.ph_hi)
#define PSYNC(k) do { if ((k) > P.ph_lo) grid.sync(); } while (0)
#if !defined(ONLY) || ONLY == 0
    PHASE(0) { PSYNC(0); phase_prep(P, lds); }
#endif
#if !defined(ONLY) || ONLY == 1
    PHASE(1) { PSYNC(1); phase_rows<0>(P, 0, 0, 0, 0, 0, false); }
#endif
#if !defined(ONLY) || ONLY == 2
    PHASE(2) { PSYNC(2); { EpiB16<0> e; e.O = PB; e.ldc = LDP0; run_gemm(lds, ABUF, (const bf16_t*)(P.ws + WS_WAB), 3328, 1024, false, e); } }
#endif
#if !defined(ONLY) || ONLY == 3
    PHASE(3) { PSYNC(3); for (int ch = blockIdx.x; ch < 256; ch += gridDim.x) rwkv_chain(P, lds, ch);
                phase_rope(PB, LDP0, 1792, 16); phase_vt(PB, LDP0, 1792 + 1024, 4, 128, (bf16_t*)(P.ws + WS_BIG + BIG_VT0)); }
#endif
#if !defined(ONLY) || ONLY == 4
    PHASE(4) { PSYNC(4); phase_diff_attn(P); phase_rwkv_finish(P, lds); }
#endif
#if !defined(ONLY) || ONLY == 5
    PHASE(5) { PSYNC(5); { EpiResid e = make_resid(P, 0, 2 * 1024, 1); run_gemm(lds, ABUF, (const bf16_t*)(P.ws + WS_WOUT), 1024, 1024, false, e); } }
#endif
#if !defined(ONLY) || ONLY == 6
    PHASE(6) { PSYNC(6); phase_rows<1>(P, 0, I_LNMG, I_LNMB, 0, 3 * 1024, false); }
#endif
#if !defined(ONLY) || ONLY == 7
    PHASE(7) { PSYNC(7); { EpiB16<1> e; e.O = PB; e.ldc = 4096; run_gemm(lds, ABUF, (const bf16_t*)(P.ws + WS_W1), 4096, 1024, false, e); } }
#endif
#if !defined(ONLY) || ONLY == 8
    PHASE(8) { PSYNC(8); { EpiResid e = make_resid(P, 0, 5 * 1024, 0); run_gemm(lds, PB, (const bf16_t*)(P.ws + WS_W2), 1024, 4096, false, e); } }
#endif
#if !defined(ONLY) || ONLY == 9
    PHASE(9) { PSYNC(9); phase_rows<1>(P, 0, I_LNFG, I_LNFB, 1, 0, false); }
#endif
#if !defined(ONLY) || ONLY == 10
    PHASE(10) { PSYNC(10); { EpiB16<0> e; e.O = PB; e.ldc = LDP1; run_gemm(lds, ABUF, (const bf16_t*)(P.ws + WS_WCD), 2560, 1024, false, e); } }
#endif
#if !defined(ONLY) || ONLY == 11
    PHASE(11) { PSYNC(11); phase_conv(P); phase_rope(PB, LDP1, 1552, 10); phase_vt(PB, LDP1, 1552 + 512 + 128, 2, 64, (bf16_t*)(P.ws + WS_BIG + BIG_VT1)); }
#endif
#if !defined(ONLY) || ONLY == 12
    PHASE(12) { PSYNC(12); for (int ch = blockIdx.x; ch < 256; ch += gridDim.x) ssd_chain(P, lds, ch);
                 phase_swa(P); }
#endif
#if !defined(ONLY) || ONLY == 13
    PHASE(13) { PSYNC(13); phase_ssd_finish(P); }
#endif
#if !defined(ONLY) || ONLY == 14
    PHASE(14) { PSYNC(14); { EpiResid e = make_resid(P, 1, 2 * 1024, 0); run_gemm(lds, ABUF, (const bf16_t*)(P.ws + WS_WOUT) + (size_t)1024 * 1024, 1024, 1024, true, e); } }
#endif
#if !defined(ONLY) || ONLY == 15
    PHASE(15) { PSYNC(15); phase_rows<1>(P, 1, I_LNMG, I_LNMB, 1, 3 * 1024, true); }
#endif
#if !defined(ONLY) || ONLY == 16
    PHASE(16) { PSYNC(16); { EpiB16<1> e; e.O = PB; e.ldc = 4096; run_gemm(lds, ABUF, (const bf16_t*)(P.ws + WS_W1) + (size_t)4096 * 1024, 4096, 1024, true, e); } }
#endif
#if !defined(ONLY) || ONLY == 17
    PHASE(17) { PSYNC(17); { EpiResid e = make_resid(P, 1, 5 * 1024, 0); run_gemm(lds, PB, (const bf16_t*)(P.ws + WS_W2) + (size_t)4096 * 1024, 1024, 4096, true, e); } }
#endif
#if !defined(ONLY) || ONLY == 18
    PHASE(18) { PSYNC(18); phase_rows<2>(P, 1, I_LNFG, I_LNFB, 0, 0, true); }
#endif
}

#ifndef COOP
#define COOP 0
#endif
extern "C" void kernel_launch(void* const* d_in, const int* in_sizes, int n_in, void* d_out, int out_size, void* d_ws, size_t ws_size, hipStream_t stream) {
    static int grid = 0;
    if (grid == 0) {
        if (n_in != 38 || ws_size < WS_NEED) { fprintf(stderr, "kernel_launch: n_in %d ws %zu need %zu\n", n_in, ws_size, (size_t)WS_NEED); grid = -1; return; }
        int dev = 0, cus = 0, per_cu = 0;
        hipGetDevice(&dev); hipDeviceGetAttribute(&cus, hipDeviceAttributeMultiprocessorCount, dev);
        if (hipFuncSetAttribute((const void*)mega, hipFuncAttributeMaxDynamicSharedMemorySize, LDS_BYTES) != hipSuccess) { fprintf(stderr, "hipFuncSetAttribute failed\n"); grid = -1; return; }
        hipOccupancyMaxActiveBlocksPerMultiprocessor(&per_cu, (const void*)mega, 512, LDS_BYTES);
        (void)hipGetLastError();
        if (per_cu < 1) per_cu = 1;
        grid = cus * 1;
    }
    if (grid < 0) return;
    Params p{};
    for (int i = 0; i < 38; ++i) p.in[i] = (const float*)d_in[i];
    p.out = (float*)d_out; p.ws = (unsigned char*)d_ws;
#if COOP
    p.ph_lo = 0; p.ph_hi = NPH;
    void* args[] = {&p};
    hipError_t e = hipLaunchCooperativeKernel((const void*)mega, dim3(grid), dim3(512), args, LDS_BYTES, stream);
    if (e != hipSuccess) fprintf(stderr, "cooperative launch failed: %s (grid %d)\n", hipGetErrorString(e), grid);
#else
    for (int ph = 0; ph < NPH; ++ph) { p.ph_lo = ph; p.ph_hi = ph + 1; hipLaunchKernelGGL(mega, dim3(grid), dim3(512), LDS_BYTES, stream, p); }
#endif
}
```

```cpp
#include <hip/hip_runtime.h>
#include <hip/hip_cooperative_groups.h>
#include <cstdio>
#include <cstdint>
namespace cg = cooperative_groups;
namespace pg8 {
#define PG8_LAS __attribute__((address_space(3)))
typedef unsigned short bf16_t;
typedef short bf16x8 __attribute__((ext_vector_type(8)));
typedef float f32x4 __attribute__((ext_vector_type(4)));
typedef unsigned u32x4 __attribute__((ext_vector_type(4)));
constexpr int BM = 256, BK = 64, HALF = 128, HTB = HALF * BK * 2  , STAGE_BYTES = 8 * HTB, NXCD = 8, WGM = 8;

__host__ __device__ __forceinline__ int lds_byte(int r, int c) { const int st = (r >> 4) * 2 + (c >> 5), rr = r & 15, cc = c & 31, ob = rr * 64 + cc * 2; return st * 1024 + (ob ^ (((ob >> 9) & 1) << 5)); }
__host__ __device__ __forceinline__ void stage_rc(int b, int& R, int& C) { const int st = b / 1024, sb = b % 1024, swz = sb ^ (((sb >> 9) & 1) << 5); R = (st >> 1) * 16 + swz / 64; C = (st & 1) * 32 + (swz % 64) / 2; }
__host__ __device__ __forceinline__ int perm32(int rho) { const int n = rho >> 4, i = rho & 15; return 8 * (i >> 2) + 4 * n + (i & 3); }

struct Unit { int pm, pn, kq; };
struct Gemm { const bf16_t* A; const bf16_t* Bt; int M, N, K, ld; };

__device__ __forceinline__ unsigned cvt_pk_bf16(float lo, float hi) { unsigned r; asm volatile("v_cvt_pk_bf16_f32 %0, %1, %2" : "=v"(r) : "v"(lo), "v"(hi)); return r; }
template <class Epi, class Sched, bool STAMP = false>
__device__ __forceinline__ void gemm_phase(PG8_LAS unsigned char* lds, const Gemm g, const Sched& S, const Epi& E, unsigned long long* stamps) {
    const int tid = threadIdx.x, wid = __builtin_amdgcn_readfirstlane(tid >> 6), lane = tid & 63, wr = wid >> 2, wc = wid & 3, fr = lane & 15, fq = lane >> 4;
    const int K = g.ld, nt = g.K / BK;
    int ts_lo = 0, ts_hi = 0, nts = 0; const unsigned long long rt_entry = STAMP ? (unsigned long long)wall_clock64() : 0ull;
#define PG8_STAMP() do { if (STAMP && wid == 0 && nts < 64) { const unsigned long long _c = (unsigned long long)clock64(); \
        ts_lo = (lane == nts) ? (int)(unsigned)_c : ts_lo; ts_hi = (lane == nts) ? (int)(unsigned)(_c >> 32) : ts_hi; ++nts; } } while (0)
    PG8_STAMP();
    unsigned voffA[2], voffB[2];
#pragma unroll
    for (int i = 0; i < 2; ++i) { int R, C; stage_rc(tid * 16 + i * 8192, R, C); const int Rb = Epi::PERM ? ((R & ~31) + perm32(R & 31)) : R;
        voffA[i] = (unsigned)(R * K + C) * 2u; voffB[i] = (unsigned)(Rb * K + C) * 2u; }
    const size_t kstep = (size_t)(BK * 2);
    const size_t hstep = (size_t)HALF * K * 2;
    const size_t tstep = 2 * hstep;
    const unsigned ldsw = (unsigned)wid * 1024u;
    const int aoff = lds_byte(wr * 64 + fr, fq * 8), boff = lds_byte(wc * 32 + fr, fq * 8);
#define PG8_SA(b, h) (((b) * 2 + (h)) * HTB)
#define PG8_SB(b, h) ((4 + (b) * 2 + (h)) * HTB)
#define PG8_STAGE(bufoff, gbase, voff) do { _Pragma("unroll") for (int _i = 0; _i < 2; ++_i) \
        __builtin_amdgcn_global_load_lds((const unsigned*)((const char*)(gbase) + (voff)[_i]), (PG8_LAS unsigned*)(lds + (bufoff) + ldsw + _i * 8192), 16, 0, 0); } while (0)
#define PG8_LDA(dst, b, h) do { _Pragma("unroll") for (int m = 0; m < 4; ++m) _Pragma("unroll") for (int k = 0; k < 2; ++k) dst[m][k] = *(const PG8_LAS bf16x8*)(lds + PG8_SA(b, h) + aoff + m * 2048 + k * 1024); } while (0)
#define PG8_LDB(dst, b, h) do { _Pragma("unroll") for (int n = 0; n < 2; ++n) _Pragma("unroll") for (int k = 0; k < 2; ++k) dst[n][k] = *(const PG8_LAS bf16x8*)(lds + PG8_SB(b, h) + boff + n * 2048 + k * 1024); } while (0)
#define PG8_MMA(ai, bj, At, Bt) do { __builtin_amdgcn_s_setprio(1); _Pragma("unroll") for (int m = 0; m < 4; ++m) _Pragma("unroll") for (int n = 0; n < 2; ++n) _Pragma("unroll") for (int k = 0; k < 2; ++k) \
        acc[ai][bj][m][n] = __builtin_amdgcn_mfma_f32_16x16x32_bf16(Bt[n][k], At[m][k], acc[ai][bj][m][n], 0, 0, 0); __builtin_amdgcn_s_setprio(0); } while (0)
#define PG8_WAIT_V(n) asm volatile("s_waitcnt vmcnt(" #n ")" ::: "memory")
#define PG8_WAIT_L(n) asm volatile("s_waitcnt lgkmcnt(" #n ")" ::: "memory")
#define PG8_BAR __builtin_amdgcn_s_barrier()
#define PG8_SCHED __builtin_amdgcn_sched_barrier(0)
    Unit cur, nxt; int ui = 0;
    if (!S.next(0, cur)) return;
    f32x4 acc[2][2][4][2];
#pragma unroll
    for (int a = 0; a < 2; ++a)
#pragma unroll
        for (int b = 0; b < 2; ++b)
#pragma unroll
            for (int m = 0; m < 4; ++m)
#pragma unroll
                for (int n = 0; n < 2; ++n) acc[a][b][m][n] = (f32x4){0.f, 0.f, 0.f, 0.f};
    bf16x8 At[4][2], B0[2][2], B1[2][2];
    const size_t kqb = (size_t)g.K * 2;
    const char* cA = (const char*)g.A + (size_t)cur.pm * tstep + cur.kq * kqb; const char* cB = (const char*)g.Bt + (size_t)cur.pn * tstep + cur.kq * kqb;
    S.a_ready(cur);
    PG8_STAGE(PG8_SB(0, 0), cB, voffB); PG8_STAGE(PG8_SA(0, 0), cA, voffA); PG8_STAGE(PG8_SB(0, 1), cB + hstep, voffB); PG8_STAGE(PG8_SA(0, 1), cA + hstep, voffA);
    if (wr == 1) PG8_BAR;
    PG8_WAIT_V(4); PG8_BAR;
    PG8_STAGE(PG8_SB(1, 0), cB + kstep, voffB); PG8_STAGE(PG8_SA(1, 0), cA + kstep, voffA); PG8_STAGE(PG8_SB(1, 1), cB + hstep + kstep, voffB);
    PG8_WAIT_V(6); PG8_BAR;
    PG8_STAMP();
    for (;;) {
        const bool has_next = S.next(ui + 1, nxt);
        const char* nA = has_next ? (const char*)g.A + (size_t)nxt.pm * tstep + nxt.kq * kqb : cA; const char* nB = has_next ? (const char*)g.Bt + (size_t)nxt.pn * tstep + nxt.kq * kqb : cB;
        for (int t = 0; t < nt; t += 2) {
            const bool last = (t == nt - 2);
            const char* a1 = cA + (size_t)(t + 1) * kstep;
            const char* a2 = last ? nA : cA + (size_t)(t + 2) * kstep; const char* b2 = last ? nB : cB + (size_t)(t + 2) * kstep;
            const char* a3 = a2 + kstep; const char* b3 = b2 + kstep;
            if (last && has_next) S.a_ready(nxt);
            PG8_LDB(B0, 0, 0); PG8_SCHED; PG8_LDA(At, 0, 0); PG8_STAGE(PG8_SA(1, 1), a1 + hstep, voffA);
            PG8_WAIT_L(8); PG8_BAR; PG8_WAIT_L(0); PG8_MMA(0, 0, At, B0); PG8_BAR; PG8_SCHED;
            PG8_LDB(B1, 0, 1); PG8_STAGE(PG8_SB(0, 0), b2, voffB);
            PG8_BAR; PG8_WAIT_L(0); PG8_MMA(0, 1, At, B1); PG8_BAR;
            PG8_LDA(At, 0, 1); PG8_STAGE(PG8_SA(0, 0), a2, voffA);
            PG8_BAR; PG8_WAIT_L(0); PG8_MMA(1, 0, At, B0); PG8_BAR; PG8_SCHED;
            PG8_STAGE(PG8_SB(0, 1), b2 + hstep, voffB);
            PG8_WAIT_V(6); PG8_BAR; PG8_MMA(1, 1, At, B1); PG8_BAR;
            PG8_LDB(B0, 1, 0); PG8_SCHED; PG8_LDA(At, 1, 0); PG8_STAGE(PG8_SA(0, 1), a2 + hstep, voffA);
            PG8_WAIT_L(8); PG8_BAR; PG8_WAIT_L(0); PG8_MMA(0, 0, At, B0); PG8_BAR; PG8_SCHED;
            PG8_LDB(B1, 1, 1); PG8_STAGE(PG8_SB(1, 0), b3, voffB);
            PG8_BAR; PG8_WAIT_L(0); PG8_MMA(0, 1, At, B1); PG8_BAR;
            PG8_LDA(At, 1, 1); PG8_STAGE(PG8_SA(1, 0), a3, voffA);
            PG8_BAR; PG8_WAIT_L(0); PG8_MMA(1, 0, At, B0); PG8_BAR; PG8_SCHED;
            PG8_STAGE(PG8_SB(1, 1), b3 + hstep, voffB);
            PG8_WAIT_V(6); PG8_BAR; PG8_MMA(1, 1, At, B1); PG8_BAR;
        }
        PG8_STAMP();
        if constexpr (!Epi::AFTER_DRAIN) { E(acc, cur, wr, wc, fr, fq); S.done(cur); }
        PG8_STAMP();
        if (!has_next) break;
#pragma unroll
        for (int a = 0; a < 2; ++a)
#pragma unroll
            for (int b = 0; b < 2; ++b)
#pragma unroll
                for (int m = 0; m < 4; ++m)
#pragma unroll
                    for (int n = 0; n < 2; ++n) acc[a][b][m][n] = (f32x4){0.f, 0.f, 0.f, 0.f};
        cur = nxt; cA = nA; cB = nB; ++ui;
    }
    PG8_WAIT_V(0);
    if (wr == 0) PG8_BAR;
    PG8_BAR;
    if constexpr (Epi::AFTER_DRAIN) { E.fused(acc, cur, wr, wc, fr, fq, lds, wid, lane); S.done(cur); }
    PG8_STAMP();
    if (STAMP && wid == 0) { stamps[lane] = lane < nts ? (((unsigned long long)(unsigned)ts_hi << 32) | (unsigned)ts_lo) : 0ull;
        if (lane == 62) stamps[62] = rt_entry; if (lane == 63) stamps[63] = (unsigned long long)wall_clock64(); }
#undef PG8_STAMP
#undef PG8_SA
#undef PG8_SB
#undef PG8_STAGE
#undef PG8_LDA
#undef PG8_LDB
#undef PG8_MMA
#undef PG8_WAIT_V
#undef PG8_WAIT_L
#undef PG8_BAR
#undef PG8_SCHED
}
}

using pg8::bf16_t; using pg8::bf16x8; using pg8::f32x4; using pg8::u32x4;
typedef float f32x16 __attribute__((ext_vector_type(16)));
typedef float f32x2 __attribute__((ext_vector_type(2)));
typedef __bf16 bf16v2 __attribute__((ext_vector_type(2)));
typedef short s16x4 __attribute__((ext_vector_type(4)));
typedef unsigned u32x2 __attribute__((ext_vector_type(2)));
#define DI __device__ __forceinline__
#define LAS __attribute__((address_space(3)))

constexpr int NB = 16, LSEQ = 2048, NCTX = 256, TT = 2304, MROWS = NB * TT, DM = 1024;
constexpr int LDP0 = 3328, LDP1 = 2560, NCD = 2320;
constexpr float ALPHA = 1.41421356237f;
constexpr float LOG2E = 1.4426950408889634f;
constexpr float C2 = 0.125f * LOG2E;
constexpr int LDS_BYTES = 147456 + 16;
constexpr int NPH = 19;
#ifndef REP_MASK
#define REP_MASK 0u
#endif
#define REP(bit) for (int rep_ = 0; rep_ < (((REP_MASK >> (bit)) & 1u) ? 2 : 1); ++rep_)

constexpr size_t WS_MOD = 0;
constexpr size_t WS_BAR = 0xD0000;
constexpr size_t WS_WAB = 1u << 20;
constexpr size_t WS_WCD = WS_WAB + (size_t)3328 * 1024 * 2;
constexpr size_t WS_WOUT = WS_WCD + (size_t)2560 * 1024 * 2;
constexpr size_t WS_W1 = WS_WOUT + (size_t)2 * 1024 * 1024 * 2;
constexpr size_t WS_W2 = WS_W1 + (size_t)2 * 4096 * 1024 * 2;
constexpr size_t WS_ABUF = WS_W2 + (size_t)2 * 4096 * 1024 * 2;
constexpr size_t WS_HCTX = WS_ABUF + (size_t)MROWS * 1024 * 2;
constexpr size_t WS_BIG = WS_HCTX + (size_t)4096 * 1024 * 4;
constexpr size_t BIG_P = 0;
constexpr size_t BIG_VT0 = (size_t)MROWS * 3328 * 2;
constexpr size_t BIG_Y0 = BIG_VT0 + (size_t)16 * 4 * 128 * 2304 * 2;
constexpr size_t BIG_END0 = BIG_Y0 + (size_t)2 * MROWS * 512 * 2;
constexpr size_t BIG_XBC = (size_t)MROWS * 2560 * 2;
constexpr size_t BIG_VT1 = BIG_XBC + (size_t)MROWS * 1024 * 2;
constexpr size_t BIG_Y1 = BIG_VT1 + (size_t)16 * 2 * 64 * 2304 * 2;
constexpr size_t BIG_END1 = BIG_Y1 + (size_t)2 * MROWS * 512 * 2;
constexpr size_t BIG_Z1 = (size_t)MROWS * 4096 * 2;
constexpr size_t BIG_ENDU = BIG_Z1 + (size_t)MROWS * 1024 * 2;
constexpr size_t BIG_MAX = BIG_END0 > BIG_ENDU ? (BIG_END0 > BIG_END1 ? BIG_END0 : BIG_END1) : (BIG_ENDU > BIG_END1 ? BIG_ENDU : BIG_END1);
constexpr size_t WS_NEED = WS_BIG + BIG_MAX;

struct Params {
    const float* in[38];
    float* out;
    unsigned char* ws;
    int ph_lo, ph_hi;
};
enum { I_X = 0, I_C, I_CTX, I_CCTX, I_MODW, I_MODB, I_LNMG, I_LNMB, I_LNFG, I_LNFB, I_W1, I_W2, I_WOUT, I_ABW, I_MU, I_RW0, I_RW2, I_RA0, I_RA2, I_RG2, I_RKK, I_RKA, I_RRK, I_GNG, I_GNB,
       I_LQ1, I_LK1, I_LQ2, I_LK2, I_SUBLN, I_CDW, I_CONVW, I_CONVB, I_DTB, I_ALOG, I_SSDD, I_NORMG, I_SINK };

DI float bf2f(bf16_t v) { return __uint_as_float(((unsigned)v) << 16); }
DI unsigned pk2(float a, float b) { f32x2 v = {a, b}; bf16v2 r = __builtin_convertvector(v, bf16v2); return __builtin_bit_cast(unsigned, r); }
DI bf16_t f2bf(float a) { return (bf16_t)(pk2(a, 0.f) & 0xffffu); }
DI float lo2f(unsigned u) { return __uint_as_float(u << 16); }
DI float hi2f(unsigned u) { return __uint_as_float(u & 0xffff0000u); }
typedef _Float16 f16v2 __attribute__((ext_vector_type(2)));
DI unsigned pkh2(float a, float b) { f32x2 v = {a, b}; f16v2 r = __builtin_convertvector(v, f16v2); return __builtin_bit_cast(unsigned, r); }
DI f32x2 uph2(unsigned u) { const f16v2 h = __builtin_bit_cast(f16v2, u); return __builtin_convertvector(h, f32x2); }
DI float sigmoidf_(float x) { return 1.0f / (1.0f + __expf(-x)); }
DI float siluf_(float x) { return x * sigmoidf_(x); }
DI float softplusf_(float x) { return fmaxf(x, 0.f) + __logf(1.0f + __expf(-fabsf(x))); }
DI float tanhf_(float x) { const float e = __expf(2.0f * x); return 1.0f - 2.0f / (1.0f + e); }
DI float wave_sum(float v) {
#pragma unroll
    for (int o = 1; o < 64; o <<= 1) v += __shfl_xor(v, o);
    return v;
}
DI float dpp_x1(float v) { return __int_as_float(__builtin_amdgcn_update_dpp(0, __float_as_int(v), 0xB1, 0xF, 0xF, true)); }
DI float dpp_x2(float v) { return __int_as_float(__builtin_amdgcn_update_dpp(0, __float_as_int(v), 0x4E, 0xF, 0xF, true)); }
DI float dpp_hm(float v) { return __int_as_float(__builtin_amdgcn_update_dpp(0, __float_as_int(v), 0x141, 0xF, 0xF, true)); }
DI float dpp_rm(float v) { return __int_as_float(__builtin_amdgcn_update_dpp(0, __float_as_int(v), 0x140, 0xF, 0xF, true)); }
DI float wave_sum_fast(float v) {
    v += dpp_x1(v); v += dpp_x2(v); v += dpp_hm(v); v += dpp_rm(v);
    { auto r = __builtin_amdgcn_permlane16_swap(__float_as_uint(v), __float_as_uint(v), false, false); v = __uint_as_float(r[0]) + __uint_as_float(r[1]); }
    { auto r = __builtin_amdgcn_permlane32_swap(__float_as_uint(v), __float_as_uint(v), false, false); v = __uint_as_float(r[0]) + __uint_as_float(r[1]); }
    return v;
}
DI void unpack8(const u32x4 v, float (&f)[8]) { f[0] = lo2f(v.x); f[1] = hi2f(v.x); f[2] = lo2f(v.y); f[3] = hi2f(v.y); f[4] = lo2f(v.z); f[5] = hi2f(v.z); f[6] = lo2f(v.w); f[7] = hi2f(v.w); }
DI float dpp_ror4(float v) { return __int_as_float(__builtin_amdgcn_update_dpp(0, __float_as_int(v), 0x124, 0xF, 0xF, true)); }
DI float dpp_ror8(float v) { return __int_as_float(__builtin_amdgcn_update_dpp(0, __float_as_int(v), 0x128, 0xF, 0xF, true)); }
DI float reduce16(float v) { v += dpp_x1(v); v += dpp_x2(v); v += dpp_ror4(v); v += dpp_ror8(v); return v; }
DI float reduce8(float v) { v += dpp_x1(v); v += dpp_x2(v); v += dpp_hm(v); return v; }
DI int crow(int r, int hi) { return (r & 3) + 8 * (r >> 2) + 4 * hi; }
#define MFMA32(a, b, c) __builtin_amdgcn_mfma_f32_32x32x16_bf16((a), (b), (c), 0, 0, 0)

DI float* hrow_ptr(const Params& P, int r) {
    const int b = r / TT, t = r - b * TT;
    return t < NCTX ? (float*)(P.ws + WS_HCTX) + ((size_t)b * NCTX + t) * DM : P.out + ((size_t)b * LSEQ + (t - NCTX)) * DM;
}
DI const float* h0row_ptr(const Params& P, int r) {
    const int b = r / TT, t = r - b * TT;
    return t < NCTX ? P.in[I_CTX] + ((size_t)b * NCTX + t) * DM : P.in[I_X] + ((size_t)b * LSEQ + (t - NCTX)) * DM;
}
DI const float* modrow_ptr(const Params& P, int layer, int r) {
    const int b = r / TT, t = r - b * TT;
    return (const float*)(P.ws + WS_MOD) + ((size_t)layer * 17 + (t < NCTX ? 16 : b)) * 6144;
}

struct MyOrder {
    int nM, nN, nwg, G, c, latonly;
    DI void init(int nM_, int nN_, int G_, int c_, int latonly_) { nM = nM_; nN = nN_; nwg = nM * nN; G = G_; c = c_; latonly = latonly_; }
    DI bool next(int i, pg8::Unit& u) const {
        const long L = (long)i * G + c; if (L >= nwg) return false;
        int wgid = (int)L; { const int q = nwg / pg8::NXCD, r = nwg % pg8::NXCD, xcd = wgid % pg8::NXCD, off = wgid / pg8::NXCD; wgid = (xcd < r ? xcd * (q + 1) : r * (q + 1) + (xcd - r) * q) + off; }
        const int nig = pg8::WGM * nN, gid = wgid / nig, fm = gid * pg8::WGM, gsz = (nM - fm) < pg8::WGM ? (nM - fm) : pg8::WGM;
        int pm = fm + ((wgid % nig) % gsz); u.pn = (wgid % nig) / gsz;
        if (latonly) pm = (pm >> 3) * 9 + 1 + (pm & 7);
        u.pm = pm; u.kq = 0; return true;
    }
    DI void a_ready(const pg8::Unit&) const {}
    DI void done(const pg8::Unit&) const {}
};
template <int ACT> struct EpiB16 {
    static constexpr bool PERM = true, AFTER_DRAIN = false;
    bf16_t* O; int ldc;
    DI void operator()(const f32x4 (&acc)[2][2][4][2], const pg8::Unit& u, int wr, int wc, int fr, int fq) const {
        const int row0 = u.pm * 256 + wr * 64 + fr, col0 = u.pn * 256 + wc * 32 + 8 * fq;
#pragma unroll
        for (int ai = 0; ai < 2; ++ai)
#pragma unroll
            for (int m = 0; m < 4; ++m) { bf16_t* rowp = O + (size_t)(row0 + ai * 128 + m * 16) * ldc + col0;
#pragma unroll
                for (int bj = 0; bj < 2; ++bj) { f32x4 v0 = acc[ai][bj][m][0], v1 = acc[ai][bj][m][1];
                    if (ACT == 1) {
#pragma unroll
                        for (int j = 0; j < 4; ++j) { const float a = fmaxf(v0[j], 0.f), b = fmaxf(v1[j], 0.f); v0[j] = a * a; v1[j] = b * b; } }
                    u32x4 w; w.x = pk2(v0[0], v0[1]); w.y = pk2(v0[2], v0[3]); w.z = pk2(v1[0], v1[1]); w.w = pk2(v1[2], v1[3]);
                    *(u32x4*)(rowp + bj * 128) = w; } }
    }
};
struct EpiResid {
    static constexpr bool PERM = false, AFTER_DRAIN = false;
    const float* xin; const float* ctxin; float* hlat; float* hctx; const float* modv; int gate_off; int layer0;
    DI void operator()(const f32x4 (&acc)[2][2][4][2], const pg8::Unit& u, int wr, int wc, int fr, int fq) const {
        const int b = u.pm / 9, j = u.pm - 9 * b;
        const float* src; float* dst; const float* gate;
        if (j == 0) { const size_t o = (size_t)b * NCTX * DM; dst = hctx + o; src = layer0 ? ctxin + o : dst; gate = modv + 16 * 6144 + gate_off; }
        else { const size_t o = ((size_t)b * LSEQ + (size_t)(j - 1) * 256) * DM; dst = hlat + o; src = layer0 ? xin + o : dst; gate = modv + b * 6144 + gate_off; }
        const int rloc = wr * 64 + fr, col0 = u.pn * 256 + wc * 32 + 4 * fq;
#pragma unroll
        for (int ai = 0; ai < 2; ++ai)
#pragma unroll
            for (int m = 0; m < 4; ++m) { const size_t ro = (size_t)(rloc + ai * 128 + m * 16) * DM + col0;
#pragma unroll
                for (int bj = 0; bj < 2; ++bj)
#pragma unroll
                    for (int n = 0; n < 2; ++n) { const size_t o = ro + bj * 128 + n * 16; const f32x4 hv = *(const f32x4*)(src + o); const f32x4 gv = *(const f32x4*)(gate + col0 + bj * 128 + n * 16);
                        *(f32x4*)(dst + o) = hv * ALPHA + gv * acc[ai][bj][m][n]; }
                asm volatile("" ::: "memory"); }
    }
};

struct CtxSplitOrder {
    int G, c;
    DI bool next(int i, pg8::Unit& u) const { const int L = i * G + c; if (L >= 256) return false; u.pm = (L >> 4) * 9; u.pn = (L >> 2) & 3; u.kq = L & 3; return true; }
    DI void a_ready(const pg8::Unit&) const {}
    DI void done(const pg8::Unit&) const {}
};
struct EpiPart {
    static constexpr bool PERM = false, AFTER_DRAIN = false;
    float* slab;
    DI void operator()(const f32x4 (&acc)[2][2][4][2], const pg8::Unit& u, int wr, int wc, int fr, int fq) const {
        float* base = slab + ((size_t)u.kq * 4096 + (size_t)(u.pm / 9) * 256 + wr * 64 + fr) * DM + u.pn * 256 + wc * 32 + 4 * fq;
#pragma unroll
        for (int ai = 0; ai < 2; ++ai)
#pragma unroll
            for (int m = 0; m < 4; ++m)
#pragma unroll
                for (int bj = 0; bj < 2; ++bj)
#pragma unroll
                    for (int n = 0; n < 2; ++n) *(f32x4*)(base + (size_t)(ai * 128 + m * 16) * DM + bj * 128 + n * 16) = acc[ai][bj][m][n];
    }
};
struct EpiResid2 {
    static constexpr bool PERM = true, AFTER_DRAIN = false;
    const float* xin; const float* ctxin; const bf16_t* zsrc; bf16_t* zdst; const float* stats; const float* lng; const float* lnb; const float* modv; int gate_off; int layer0;
    DI void operator()(const f32x4 (&acc)[2][2][4][2], const pg8::Unit& u, int wr, int wc, int fr, int fq) const {
        const int b = u.pm / 9, j = u.pm - 9 * b;
        const float* gate = modv + (j == 0 ? 16 : b) * 6144 + gate_off;
        const float* src32 = j == 0 ? ctxin + (size_t)b * NCTX * DM : xin + ((size_t)b * LSEQ + (size_t)(j - 1) * 256) * DM;
        const int rloc = wr * 64 + fr, col0 = u.pn * 256 + wc * 32 + 8 * fq;
#pragma unroll
        for (int ai = 0; ai < 2; ++ai)
#pragma unroll
            for (int m = 0; m < 4; ++m) { const int rl = rloc + ai * 128 + m * 16; const size_t rowu = (size_t)u.pm * 256 + rl;
                float mean = 0.f, rstd = 1.f; if (!layer0) { const f32x2 st2 = *(const f32x2*)(stats + 2 * rowu); mean = st2.x; rstd = st2.y; }
#pragma unroll
                for (int bj = 0; bj < 2; ++bj)
#pragma unroll
                    for (int n = 0; n < 2; ++n) { const int c = col0 + bj * 128 + 4 * n; f32x4 h;
                        if (layer0) h = *(const f32x4*)(src32 + (size_t)rl * DM + c);
                        else { const u32x2 zv = *(const u32x2*)(zsrc + rowu * DM + c); const f32x2 za = uph2(zv.x), zb = uph2(zv.y); const f32x4 z = {za.x, za.y, zb.x, zb.y};
                            h = (z - mean) * rstd * *(const f32x4*)(lng + c) + *(const f32x4*)(lnb + c); }
                        const f32x4 o = h * ALPHA + *(const f32x4*)(gate + c) * acc[ai][bj][m][n];
                        u32x2 w; w.x = pkh2(o.x, o.y); w.y = pkh2(o.z, o.w); *(u32x2*)(zdst + rowu * DM + c) = w; }
                asm volatile("" ::: "memory"); }
    }
};

struct TrItem { const float* W; bf16_t* WT; int K, N, k0, n0; };
DI void tr_load(const TrItem& t, float (&v)[8]) {
    const int tid = threadIdx.x;
#pragma unroll
    for (int p = 0; p < 8; ++p) { const int kk = p * 8 + (tid >> 6), n = tid & 63; v[p] = (t.n0 + n < t.N) ? t.W[(size_t)(t.k0 + kk) * t.N + t.n0 + n] : 0.f; }
}
DI void tr_store(const TrItem& t, const float (&v)[8], float* scr  ) {
    const int tid = threadIdx.x;
    __syncthreads();
#pragma unroll
    for (int p = 0; p < 8; ++p) { const int kk = p * 8 + (tid >> 6), n = tid & 63; scr[kk * 65 + n] = v[p]; }
    __syncthreads();
    { const int n = tid >> 3, kc = tid & 7; const float* s = scr + (kc * 8) * 65 + n;
      u32x4 o; o.x = pk2(s[0], s[65]); o.y = pk2(s[2 * 65], s[3 * 65]); o.z = pk2(s[4 * 65], s[5 * 65]); o.w = pk2(s[6 * 65], s[7 * 65]);
      *(u32x4*)(t.WT + (size_t)(t.n0 + n) * t.K + t.k0 + kc * 8) = o; }
}
constexpr int TR_AB = 16 * 52, TR_WO = 16 * 16, TR_W1 = 16 * 64, TR_W2 = 64 * 16, TR_CD = 16 * 40;
constexpr int TR_A = TR_AB + TR_WO, TR_B = TR_A + TR_W1 + TR_W2, TR_C = TR_B + TR_CD + TR_WO + TR_W1, TR_D = TR_C + TR_W2;
DI TrItem tr_decode(const Params& P, int it) {
    TrItem t; int r = it; int K = 1024, N = 1024; const float* W; bf16_t* WT;
    if (r < TR_AB) { W = P.in[I_ABW]; WT = (bf16_t*)(P.ws + WS_WAB); N = 3328; }
    else if ((r -= TR_AB) < TR_WO) { W = P.in[I_WOUT]; WT = (bf16_t*)(P.ws + WS_WOUT); }
    else if ((r -= TR_WO) < TR_W1) { W = P.in[I_W1]; WT = (bf16_t*)(P.ws + WS_W1); N = 4096; }
    else if ((r -= TR_W1) < TR_W2) { W = P.in[I_W2]; WT = (bf16_t*)(P.ws + WS_W2); K = 4096; }
    else if ((r -= TR_W2) < TR_CD) { W = P.in[I_CDW]; WT = (bf16_t*)(P.ws + WS_WCD); N = NCD; }
    else if ((r -= TR_CD) < TR_WO) { W = P.in[I_WOUT] + (size_t)1024 * 1024; WT = (bf16_t*)(P.ws + WS_WOUT) + (size_t)1024 * 1024; }
    else if ((r -= TR_WO) < TR_W1) { W = P.in[I_W1] + (size_t)1024 * 4096; WT = (bf16_t*)(P.ws + WS_W1) + (size_t)1024 * 4096; N = 4096; }
    else { r -= TR_W1; W = P.in[I_W2] + (size_t)1024 * 4096; WT = (bf16_t*)(P.ws + WS_W2) + (size_t)1024 * 4096; K = 4096; }
    const int nblk_k = K / 64; const int nb = r / nblk_k, kb = r - nb * nblk_k;
    t.W = W; t.WT = WT; t.K = K; t.N = N; t.k0 = kb * 64; t.n0 = nb * 64; return t;
}
DI void transpose_range(const Params& P, float* scr, int lo, int hi, int first_block, int nblocks) {
    if ((int)blockIdx.x < first_block || nblocks <= 0) return;
    int it = lo + ((int)blockIdx.x - first_block);
    if (it >= hi) return;
    TrItem cur = tr_decode(P, it); float v[8]; tr_load(cur, v);
    for (;;) { const int nx = it + nblocks; const bool more = nx < hi;
        TrItem nxt = cur; float w[8];
        if (more) { nxt = tr_decode(P, nx); tr_load(nxt, w); }
        tr_store(cur, v, scr);
        if (!more) break;
#pragma unroll
        for (int p = 0; p < 8; ++p) v[p] = w[p];
        cur = nxt; it = nx; }
    __syncthreads();
}
DI void phase_prep(const Params& P, unsigned char* lds) {
    const int tid = threadIdx.x; float* scr = (float*)lds;
    transpose_range(P, scr, 0, TR_D, 0, gridDim.x);
    float* sc = (float*)lds;
    float* red = sc + 17 * 1024;
    bool staged = false;
    for (int it = blockIdx.x; it < 192; it += gridDim.x) {
        __syncthreads();
        if (!staged) { for (int e = tid; e < 17 * 1024; e += 512) { const int r = e >> 10, k = e & 1023; const float v = r < 16 ? P.in[I_C][r * 1024 + k] : P.in[I_CCTX][k]; sc[e] = siluf_(v); } staged = true; __syncthreads(); }
        const int layer = it / 96, col0 = (it - layer * 96) * 64; const int cgp = tid & 63, ks = tid >> 6;
        const float* W = P.in[I_MODW] + (size_t)layer * 1024 * 6144 + col0 + cgp;
        float acc[17];
#pragma unroll
        for (int r = 0; r < 17; ++r) acc[r] = 0.f;
#pragma unroll 8
        for (int k = ks * 128; k < ks * 128 + 128; ++k) { const float w = W[(size_t)k * 6144];
#pragma unroll
            for (int r = 0; r < 17; ++r) acc[r] += sc[r * 1024 + k] * w; }
#pragma unroll
        for (int r = 0; r < 17; ++r) red[(ks * 17 + r) * 64 + cgp] = acc[r];
        __syncthreads();
        for (int e = tid; e < 17 * 64; e += 512) { const int r = e >> 6, cc = e & 63; float s = P.in[I_MODB][layer * 6144 + col0 + cc];
#pragma unroll
            for (int q = 0; q < 8; ++q) s += red[(q * 17 + r) * 64 + cc];
            ((float*)(P.ws + WS_MOD))[((size_t)layer * 17 + r) * 6144 + col0 + cc] = s; }
    }
}

template <int MODE>
DI void phase_rows(const Params& P, const bf16_t* zsrc, int layer_ln, int ln_g_idx, int ln_b_idx, int layer_mod, int mod_off, bool latonly) {
    const int lane = threadIdx.x & 63, gw = blockIdx.x * 8 + (threadIdx.x >> 6), ngw = gridDim.x * 8;
    float* stats = (float*)(P.ws + WS_HCTX);
    for (int r = gw; r < MROWS; r += ngw) {
        const int bb = r / TT, t = r - bb * TT; if (latonly && t < NCTX) continue;
        float v[2][8];
        if (MODE == 0) { const float* src = h0row_ptr(P, r);
#pragma unroll
            for (int j = 0; j < 2; ++j) { const f32x4 a = *(const f32x4*)(src + 8 * (lane + 64 * j)), c = *(const f32x4*)(src + 8 * (lane + 64 * j) + 4);
                v[j][0] = a.x; v[j][1] = a.y; v[j][2] = a.z; v[j][3] = a.w; v[j][4] = c.x; v[j][5] = c.y; v[j][6] = c.z; v[j][7] = c.w; } }
        else { const bf16_t* zp = zsrc + (size_t)r * DM; float s = 0.f;
#pragma unroll
            for (int j = 0; j < 2; ++j) { { const u32x4 q4 = *(const u32x4*)(zp + 8 * (lane + 64 * j)); const f32x2 a0 = uph2(q4.x), a1 = uph2(q4.y), a2 = uph2(q4.z), a3 = uph2(q4.w);
                v[j][0] = a0.x; v[j][1] = a0.y; v[j][2] = a1.x; v[j][3] = a1.y; v[j][4] = a2.x; v[j][5] = a2.y; v[j][6] = a3.x; v[j][7] = a3.y; }
#pragma unroll
                for (int i = 0; i < 8; ++i) s += v[j][i]; }
            const float mean = wave_sum_fast(s) * (1.f / 1024.f); float s2 = 0.f;
#pragma unroll
            for (int j = 0; j < 2; ++j)
#pragma unroll
                for (int i = 0; i < 8; ++i) { v[j][i] -= mean; s2 += v[j][i] * v[j][i]; }
            const float rstd = 1.0f / sqrtf(wave_sum_fast(s2) * (1.f / 1024.f) + 1e-5f);
            if (MODE == 1 && lane == 0) *(f32x2*)(stats + 2 * (size_t)r) = (f32x2){mean, rstd};
            const float* g = P.in[ln_g_idx] + layer_ln * 1024; const float* be = P.in[ln_b_idx] + layer_ln * 1024;
#pragma unroll
            for (int j = 0; j < 2; ++j) { const int c = 8 * (lane + 64 * j); const f32x4 g0 = *(const f32x4*)(g + c), g1 = *(const f32x4*)(g + c + 4), b0 = *(const f32x4*)(be + c), b1 = *(const f32x4*)(be + c + 4);
                v[j][0] = v[j][0] * rstd * g0.x + b0.x; v[j][1] = v[j][1] * rstd * g0.y + b0.y; v[j][2] = v[j][2] * rstd * g0.z + b0.z; v[j][3] = v[j][3] * rstd * g0.w + b0.w;
                v[j][4] = v[j][4] * rstd * g1.x + b1.x; v[j][5] = v[j][5] * rstd * g1.y + b1.y; v[j][6] = v[j][6] * rstd * g1.z + b1.z; v[j][7] = v[j][7] * rstd * g1.w + b1.w; } }
        if (MODE == 2) { float* op = P.out + ((size_t)bb * LSEQ + (t - NCTX)) * DM;
#pragma unroll
            for (int j = 0; j < 2; ++j) { const int c = 8 * (lane + 64 * j); *(f32x4*)(op + c) = (f32x4){v[j][0], v[j][1], v[j][2], v[j][3]}; *(f32x4*)(op + c + 4) = (f32x4){v[j][4], v[j][5], v[j][6], v[j][7]}; } }
        else { const float* mv = modrow_ptr(P, layer_mod, r) + mod_off; bf16_t* ap = (bf16_t*)(P.ws + WS_ABUF) + (size_t)r * DM;
#pragma unroll
            for (int j = 0; j < 2; ++j) { const int c = 8 * (lane + 64 * j); const f32x4 h0 = *(const f32x4*)(mv + c), h1 = *(const f32x4*)(mv + c + 4), c0 = *(const f32x4*)(mv + 1024 + c), c1 = *(const f32x4*)(mv + 1024 + c + 4);
                u32x4 w; w.x = pk2(v[j][0] * (c0.x + 1.0f) + h0.x, v[j][1] * (c0.y + 1.0f) + h0.y); w.y = pk2(v[j][2] * (c0.z + 1.0f) + h0.z, v[j][3] * (c0.w + 1.0f) + h0.w);
                w.z = pk2(v[j][4] * (c1.x + 1.0f) + h1.x, v[j][5] * (c1.y + 1.0f) + h1.y); w.w = pk2(v[j][6] * (c1.z + 1.0f) + h1.z, v[j][7] * (c1.w + 1.0f) + h1.w);
                *(u32x4*)(ap + c) = w; } }
    }
}

DI void phase_rows_ctx(const Params& P, const bf16_t* zsrc, const float* slab) {
    const int lane = threadIdx.x & 63, gw = blockIdx.x * 8 + (threadIdx.x >> 6), ngw = gridDim.x * 8;
    const float* stats = (const float*)(P.ws + WS_HCTX);
    const float* g1 = P.in[I_LNMG]; const float* b1 = P.in[I_LNMB]; const float* g2 = P.in[I_LNFG]; const float* b2 = P.in[I_LNFB];
    const float* gate = (const float*)(P.ws + WS_MOD) + 16 * 6144 + 5 * 1024;
    const float* mv = (const float*)(P.ws + WS_MOD) + ((size_t)17 + 16) * 6144;
    for (int rc = gw; rc < NB * NCTX; rc += ngw) {
        const int bb = rc >> 8, t = rc & 255; const size_t r = (size_t)bb * TT + t;
        const f32x2 st2 = *(const f32x2*)(stats + 2 * r);
        float v[2][8]; float s = 0.f;
#pragma unroll
        for (int j = 0; j < 2; ++j) { const int c = 8 * (lane + 64 * j);
            const u32x4 q4 = *(const u32x4*)(zsrc + r * DM + c); const f32x2 a0 = uph2(q4.x), a1 = uph2(q4.y), a2 = uph2(q4.z), a3 = uph2(q4.w);
            const float z[8] = {a0.x, a0.y, a1.x, a1.y, a2.x, a2.y, a3.x, a3.y};
            f32x4 f0 = {0.f, 0.f, 0.f, 0.f}, f1 = {0.f, 0.f, 0.f, 0.f};
#pragma unroll
            for (int kq = 0; kq < 4; ++kq) { const float* sp = slab + ((size_t)kq * 4096 + rc) * DM + c; f0 += *(const f32x4*)sp; f1 += *(const f32x4*)(sp + 4); }
            const float f[8] = {f0.x, f0.y, f0.z, f0.w, f1.x, f1.y, f1.z, f1.w};
            const f32x4 ga = *(const f32x4*)(g1 + c), gb = *(const f32x4*)(g1 + c + 4), ba = *(const f32x4*)(b1 + c), bbv = *(const f32x4*)(b1 + c + 4), ta = *(const f32x4*)(gate + c), tb = *(const f32x4*)(gate + c + 4);
            const float gg[8] = {ga.x, ga.y, ga.z, ga.w, gb.x, gb.y, gb.z, gb.w}, be[8] = {ba.x, ba.y, ba.z, ba.w, bbv.x, bbv.y, bbv.z, bbv.w}, gt[8] = {ta.x, ta.y, ta.z, ta.w, tb.x, tb.y, tb.z, tb.w};
#pragma unroll
            for (int i = 0; i < 8; ++i) { const float h = (z[i] - st2.x) * st2.y * gg[i] + be[i]; v[j][i] = ALPHA * h + gt[i] * f[i]; s += v[j][i]; } }
        const float mean = wave_sum_fast(s) * (1.f / 1024.f); float s2 = 0.f;
#pragma unroll
        for (int j = 0; j < 2; ++j)
#pragma unroll
            for (int i = 0; i < 8; ++i) { v[j][i] -= mean; s2 += v[j][i] * v[j][i]; }
        const float rstd = 1.0f / sqrtf(wave_sum_fast(s2) * (1.f / 1024.f) + 1e-5f);
        bf16_t* ap = (bf16_t*)(P.ws + WS_ABUF) + r * DM;
#pragma unroll
        for (int j = 0; j < 2; ++j) { const int c = 8 * (lane + 64 * j);
            const f32x4 ga = *(const f32x4*)(g2 + c), gb = *(const f32x4*)(g2 + c + 4), ba = *(const f32x4*)(b2 + c), bbv = *(const f32x4*)(b2 + c + 4);
            const f32x4 h0 = *(const f32x4*)(mv + c), h1 = *(const f32x4*)(mv + c + 4), c0 = *(const f32x4*)(mv + 1024 + c), c1 = *(const f32x4*)(mv + 1024 + c + 4);
            const float o0 = (v[j][0] * rstd * ga.x + ba.x) * (c0.x + 1.0f) + h0.x, o1 = (v[j][1] * rstd * ga.y + ba.y) * (c0.y + 1.0f) + h0.y, o2 = (v[j][2] * rstd * ga.z + ba.z) * (c0.z + 1.0f) + h0.z, o3 = (v[j][3] * rstd * ga.w + ba.w) * (c0.w + 1.0f) + h0.w;
            const float o4 = (v[j][4] * rstd * gb.x + bbv.x) * (c1.x + 1.0f) + h1.x, o5 = (v[j][5] * rstd * gb.y + bbv.y) * (c1.y + 1.0f) + h1.y, o6 = (v[j][6] * rstd * gb.z + bbv.z) * (c1.z + 1.0f) + h1.z, o7 = (v[j][7] * rstd * gb.w + bbv.w) * (c1.w + 1.0f) + h1.w;
            u32x4 w; w.x = pk2(o0, o1); w.y = pk2(o2, o3); w.z = pk2(o4, o5); w.w = pk2(o6, o7); *(u32x4*)(ap + c) = w; }
    }
}

DI void phase_rope(bf16_t* Pb, int ldp, int col0, int nvec) {
    const long total = (long)NB * LSEQ * nvec * 2; const long stride = (long)gridDim.x * 512;
    for (long e = (long)blockIdx.x * 512 + threadIdx.x; e < total; e += stride) {
        const int jq = (int)(e & 1); long q = e >> 1; const int vi = (int)(q % nvec); q /= nvec; const int i = (int)(q % LSEQ), b = (int)(q / LSEQ);
        bf16_t* p = Pb + (size_t)(b * TT + NCTX + i) * ldp + col0 + vi * 64 + jq * 8;
        float x0[8], x1[8], x2[8], x3[8];
        unpack8(*(const u32x4*)p, x0); unpack8(*(const u32x4*)(p + 16), x1); unpack8(*(const u32x4*)(p + 32), x2); unpack8(*(const u32x4*)(p + 48), x3);
        const float fr = (float)(i >> 6), fc = (float)(i & 63);
        float o0[8], o1[8], o2[8], o3[8];
#pragma unroll
        for (int j = 0; j < 8; ++j) { const float inv = exp2f(-(float)(jq * 8 + j) * (13.287712379549449f / 16.0f));
            const float ar = fr * inv, ac = fc * inv; const float cr = __cosf(ar), sr = __sinf(ar), cc = __cosf(ac), sc = __sinf(ac);
            o0[j] = x0[j] * cr - x1[j] * sr; o1[j] = x1[j] * cr + x0[j] * sr; o2[j] = x2[j] * cc - x3[j] * sc; o3[j] = x3[j] * cc + x2[j] * sc; }
        u32x4 w;
        w.x = pk2(o0[0], o0[1]); w.y = pk2(o0[2], o0[3]); w.z = pk2(o0[4], o0[5]); w.w = pk2(o0[6], o0[7]); *(u32x4*)p = w;
        w.x = pk2(o1[0], o1[1]); w.y = pk2(o1[2], o1[3]); w.z = pk2(o1[4], o1[5]); w.w = pk2(o1[6], o1[7]); *(u32x4*)(p + 16) = w;
        w.x = pk2(o2[0], o2[1]); w.y = pk2(o2[2], o2[3]); w.z = pk2(o2[4], o2[5]); w.w = pk2(o2[6], o2[7]); *(u32x4*)(p + 32) = w;
        w.x = pk2(o3[0], o3[1]); w.y = pk2(o3[2], o3[3]); w.z = pk2(o3[4], o3[5]); w.w = pk2(o3[6], o3[7]); *(u32x4*)(p + 48) = w;
    }
}
template <int DV>
DI void phase_vt(const bf16_t* Pb, int ldp, int vcol0, int nh, bf16_t* Vt, unsigned char* lds) {
    bf16_t* tile = (bf16_t*)lds; constexpr int RS = DV + 2;
    constexpr int NCH = 64 * (DV / 8) / 512;
    const int tid = threadIdx.x; const int nitems = NB * nh * (TT / 64);
    u32x4 pv[NCH];
#define VT_LOAD(it_) do { const int kb_ = (it_) % (TT / 64); const int q_ = (it_) / (TT / 64); const int hh_ = q_ % nh, b_ = q_ / nh; \
        _Pragma("unroll") for (int j_ = 0; j_ < NCH; ++j_) { const int e_ = tid + 512 * j_; const int key_ = e_ / (DV / 8), c8_ = (e_ % (DV / 8)) * 8; \
            pv[j_] = *(const u32x4*)(Pb + (size_t)(b_ * TT + kb_ * 64 + key_) * ldp + vcol0 + hh_ * DV + c8_); } } while (0)
    if ((int)blockIdx.x < nitems) VT_LOAD(blockIdx.x);
    for (int it = blockIdx.x; it < nitems; it += gridDim.x) {
        const int kb = it % (TT / 64); const int q = it / (TT / 64); const int hh = q % nh, b = q / nh;
        __syncthreads();
#pragma unroll
        for (int j = 0; j < NCH; ++j) { const int e = tid + 512 * j; const int key = e / (DV / 8), c8 = (e % (DV / 8)) * 8;
            unsigned* d = (unsigned*)(tile + key * RS + c8); d[0] = pv[j].x; d[1] = pv[j].y; d[2] = pv[j].z; d[3] = pv[j].w; }
        __syncthreads();
        if (it + (int)gridDim.x < nitems) VT_LOAD(it + gridDim.x);
        for (int e = tid; e < DV * 8; e += 512) { const int d = e >> 3, kc = e & 7; const bf16_t* t = tile + (kc * 8) * RS + d;
            u32x4 o; o.x = (unsigned)t[0] | ((unsigned)t[RS] << 16); o.y = (unsigned)t[2 * RS] | ((unsigned)t[3 * RS] << 16); o.z = (unsigned)t[4 * RS] | ((unsigned)t[5 * RS] << 16); o.w = (unsigned)t[6 * RS] | ((unsigned)t[7 * RS] << 16);
            *(u32x4*)(Vt + ((size_t)(b * nh + hh) * DV + d) * TT + kb * 64 + kc * 8) = o; }
    }
#undef VT_LOAD
    __syncthreads();
}
DI void phase_conv(const Params& P) {
    const bf16_t* Pb = (const bf16_t*)(P.ws + WS_BIG + BIG_P); bf16_t* X = (bf16_t*)(P.ws + WS_BIG + BIG_XBC);
    const long total = (long)MROWS * 128; const long stride = (long)gridDim.x * 512;
    for (long e = (long)blockIdx.x * 512 + threadIdx.x; e < total; e += stride) {
        const int c8 = (int)(e & 127) * 8; const int r = (int)(e >> 7); const int t = r % TT; const int lo = t < NCTX ? 0 : NCTX, hi = t < NCTX ? NCTX : TT;
        float acc[8];
        { const f32x4 b0 = *(const f32x4*)(P.in[I_CONVB] + c8), b1 = *(const f32x4*)(P.in[I_CONVB] + c8 + 4);
          acc[0] = b0.x; acc[1] = b0.y; acc[2] = b0.z; acc[3] = b0.w; acc[4] = b1.x; acc[5] = b1.y; acc[6] = b1.z; acc[7] = b1.w; }
        u32x4 xk[5];
#pragma unroll
        for (int k = 0; k < 5; ++k) { const int tq = t + k - 2; const bool ok = tq >= lo && tq < hi;
            xk[k] = *(const u32x4*)(Pb + (size_t)(r + (ok ? k - 2 : 0)) * LDP1 + 512 + c8); if (!ok) xk[k] = (u32x4){0u, 0u, 0u, 0u}; }
#pragma unroll
        for (int k = 0; k < 5; ++k) { const u32x4 xv = xk[k];
            const f32x4 w0 = *(const f32x4*)(P.in[I_CONVW] + k * 1024 + c8), w1 = *(const f32x4*)(P.in[I_CONVW] + k * 1024 + c8 + 4);
            acc[0] += lo2f(xv.x) * w0.x; acc[1] += hi2f(xv.x) * w0.y; acc[2] += lo2f(xv.y) * w0.z; acc[3] += hi2f(xv.y) * w0.w;
            acc[4] += lo2f(xv.z) * w1.x; acc[5] += hi2f(xv.z) * w1.y; acc[6] += lo2f(xv.w) * w1.z; acc[7] += hi2f(xv.w) * w1.w; }
        u32x4 o; o.x = pk2(siluf_(acc[0]), siluf_(acc[1])); o.y = pk2(siluf_(acc[2]), siluf_(acc[3])); o.z = pk2(siluf_(acc[4]), siluf_(acc[5])); o.w = pk2(siluf_(acc[6]), siluf_(acc[7]));
        *(u32x4*)(X + (size_t)r * 1024 + c8) = o;
    }
}

template <int NMAP, int NDB, bool WIN>
DI void attn_tiles(f32x16 (&o)[NMAP][NDB], float (&mref)[NMAP], float (&lsum)[NMAP], const bf16x8 (&qf)[NMAP][4],
                   const bf16_t* Kb  , int ldk, const bf16_t* Vt  ,
                   int nkt, int r32, int hi, int qpos, int kpos0) {
    for (int kt = 0; kt < nkt; ++kt) {
        const bf16_t* kp = Kb + (size_t)(kt * 32 + r32) * ldk + hi * 8;
        const bf16_t* vp = Vt + (size_t)r32 * TT + kt * 32 + 4 * hi;
        bf16x8 pf[NMAP][2];
#pragma unroll
        for (int m = 0; m < NMAP; ++m) {
            bf16x8 kf[4];
#pragma unroll
            for (int s = 0; s < 4; ++s) kf[s] = *(const bf16x8*)(kp + m * 64 + s * 16);
            f32x16 st;
#pragma unroll
            for (int i = 0; i < 16; ++i) st[i] = 0.f;
#pragma unroll
            for (int s = 0; s < 4; ++s) st = MFMA32(kf[s], qf[m][s], st);
            if (WIN) {
#pragma unroll
                for (int i = 0; i < 16; ++i) { const int dlt = qpos - (kpos0 + kt * 32 + crow(i, hi)); if (dlt > 128 || dlt < -128) st[i] = -INFINITY; } }
            float mx = st[0];
#pragma unroll
            for (int i = 1; i < 16; ++i) mx = fmaxf(mx, st[i]);
            mx = fmaxf(mx, __shfl_xor(mx, 32));
            if (__any((mx - mref[m]) * C2 > 8.0f)) { const float nm = fmaxf(mref[m], mx); const float f = exp2f((mref[m] - nm) * C2); lsum[m] *= f; mref[m] = nm;
#pragma unroll
                for (int db = 0; db < NDB; ++db)
#pragma unroll
                    for (int i = 0; i < 16; ++i) o[m][db][i] *= f; }
            const float nmc = -mref[m] * C2; float ls = 0.f;
#pragma unroll
            for (int i = 0; i < 16; ++i) { st[i] = __builtin_amdgcn_exp2f(st[i] * C2 + nmc); ls += st[i]; }
            lsum[m] += ls;
#pragma unroll
            for (int s = 0; s < 2; ++s) { u32x4 w; w.x = pk2(st[8 * s], st[8 * s + 1]); w.y = pk2(st[8 * s + 2], st[8 * s + 3]); w.z = pk2(st[8 * s + 4], st[8 * s + 5]); w.w = pk2(st[8 * s + 6], st[8 * s + 7]);
                pf[m][s] = __builtin_bit_cast(bf16x8, w); }
        }
#pragma unroll
        for (int db = 0; db < NDB; ++db) {
            bf16x8 vf[2];
#pragma unroll
            for (int s = 0; s < 2; ++s) { const s16x4 a = *(const s16x4*)(vp + (size_t)db * 32 * TT + 16 * s), b = *(const s16x4*)(vp + (size_t)db * 32 * TT + 16 * s + 8);
                vf[s] = __builtin_shufflevector(a, b, 0, 1, 2, 3, 4, 5, 6, 7); }
#pragma unroll
            for (int m = 0; m < NMAP; ++m)
#pragma unroll
                for (int s = 0; s < 2; ++s) o[m][db] = MFMA32(vf[s], pf[m][s], o[m][db]);
        }
    }
}
DI void diff_attn_block(const Params& P, unsigned char* lds, int b, int h, int qrow0, int nt, float lam) {
    const int tid = threadIdx.x, lane = tid & 63, wave = tid >> 6, r32 = lane & 31, hi = lane >> 5, m = wave >> 2, qt = wave & 3;
    const bf16_t* Pb = (const bf16_t*)(P.ws + WS_BIG + BIG_P);
    constexpr int KRS = 136, VRS = 68, STG = 64 * KRS + 128 * VRS;
    bf16_t* stg = (bf16_t*)lds;
    const int qrow = qrow0 + qt * 32 + r32;
    bf16_t* qs = stg + 3 * STG + (size_t)(wave * 4) * 64 * 8;
    bf16x8 qf[4];
    { const bf16_t* qp = Pb + (size_t)qrow * LDP0 + 1792 + h * 128 + m * 64 + hi * 8;
#pragma unroll
      for (int s = 0; s < 4; ++s) { float qv[8]; unpack8(*(const u32x4*)(qp + s * 16), qv);
          u32x4 w; w.x = pk2(qv[0] * C2, qv[1] * C2); w.y = pk2(qv[2] * C2, qv[3] * C2); w.z = pk2(qv[4] * C2, qv[5] * C2); w.w = pk2(qv[6] * C2, qv[7] * C2); qf[s] = __builtin_bit_cast(bf16x8, w); } }
    f32x16 o[4]; float mref = 0.f, lsum = 0.f;
#pragma unroll
    for (int db = 0; db < 4; ++db)
#pragma unroll
        for (int i = 0; i < 16; ++i) o[db][i] = 0.f;
    const bf16_t* Kg = Pb + (size_t)(b * TT) * LDP0 + 1792 + 512 + h * 128;
    const bf16_t* Vg = (const bf16_t*)(P.ws + WS_BIG + BIG_VT0) + (size_t)((b * 4 + h) * 128) * TT;
    const int kkey0 = tid >> 4, kc = (tid & 15) * 8;
    const int vd0 = tid >> 3, vc = (tid & 7) * 8;
    u32x4 kr0, kr1, vr0, vr1;
#define DA_LOAD(t) do { const bf16_t* kp_ = Kg + (size_t)((t) * 64 + kkey0) * LDP0 + kc; kr0 = *(const u32x4*)kp_; kr1 = *(const u32x4*)(kp_ + (size_t)32 * LDP0); \
        const bf16_t* vp_ = Vg + (size_t)vd0 * TT + (t) * 64 + vc; vr0 = *(const u32x4*)vp_; vr1 = *(const u32x4*)(vp_ + (size_t)64 * TT); } while (0)
#define DA_STORE(sb) do { bf16_t* ks_ = stg + (sb) * STG; *(u32x4*)(ks_ + kkey0 * KRS + kc) = kr0; *(u32x4*)(ks_ + (kkey0 + 32) * KRS + kc) = kr1; \
        bf16_t* vs_ = ks_ + 64 * KRS; *(u32x2*)(vs_ + vd0 * VRS + vc) = (u32x2){vr0.x, vr0.y}; *(u32x2*)(vs_ + vd0 * VRS + vc + 4) = (u32x2){vr0.z, vr0.w}; \
        *(u32x2*)(vs_ + (vd0 + 64) * VRS + vc) = (u32x2){vr1.x, vr1.y}; *(u32x2*)(vs_ + (vd0 + 64) * VRS + vc + 4) = (u32x2){vr1.z, vr1.w}; } while (0)
    __syncthreads();
#pragma unroll
    for (int s = 0; s < 4; ++s) *(bf16x8*)(qs + (s * 64 + lane) * 8) = qf[s];
    DA_LOAD(0); DA_STORE(0); DA_LOAD(1); DA_STORE(1);
    __syncthreads();
#define DA_QK(dst, sb, ci) do { const bf16_t* ks_ = stg + (sb) * STG; const float ci_ = (ci); \
        _Pragma("unroll") for (int kb = 0; kb < 2; ++kb) { _Pragma("unroll") for (int i = 0; i < 16; ++i) dst[kb][i] = ci_; \
            _Pragma("unroll") for (int s = 0; s < 4; ++s) { const bf16x8 kf = *(const bf16x8*)(ks_ + (kb * 32 + r32) * KRS + m * 64 + s * 16 + hi * 8); const bf16x8 qq = *(const bf16x8*)(qs + (s * 64 + lane) * 8); dst[kb] = MFMA32(kf, qq, dst[kb]); } } } while (0)
    f32x16 st[2], sn[2];
    DA_QK(st, 0, 0.f);
    int s0 = 0, s1 = 1, s2 = 2;
    for (int t = 0; t < nt; ++t) {
        if (t + 2 < nt) DA_LOAD(t + 2);
        if (t + 1 < nt) DA_QK(sn, s1, -mref);
        const bf16_t* vs = stg + s0 * STG + 64 * KRS;
        float mx = fmaxf(st[0][0], st[1][0]);
#pragma unroll
        for (int i = 1; i < 16; ++i) mx = fmaxf(mx, fmaxf(st[0][i], st[1][i]));
        mx = fmaxf(mx, __shfl_xor(mx, 32));
        if (t == 0 || __any(mx > 8.0f)) {
            const float dl = t == 0 ? mx : fmaxf(mx, 0.f); const float f = __builtin_amdgcn_exp2f(-dl); mref += dl;
#pragma unroll
            for (int i = 0; i < 16; ++i) { st[0][i] -= dl; st[1][i] -= dl; sn[0][i] -= dl; sn[1][i] -= dl; }
            lsum *= f;
#pragma unroll
            for (int db = 0; db < 4; ++db)
#pragma unroll
                for (int i = 0; i < 16; ++i) o[db][i] *= f; }
        bf16x8 pf[4]; float ls = 0.f;
#pragma unroll
        for (int kb = 0; kb < 2; ++kb) {
#pragma unroll
            for (int i = 0; i < 16; ++i) { st[kb][i] = __builtin_amdgcn_exp2f(st[kb][i]); ls += st[kb][i]; }
#pragma unroll
            for (int s = 0; s < 2; ++s) { u32x4 w; w.x = pk2(st[kb][8 * s], st[kb][8 * s + 1]); w.y = pk2(st[kb][8 * s + 2], st[kb][8 * s + 3]); w.z = pk2(st[kb][8 * s + 4], st[kb][8 * s + 5]); w.w = pk2(st[kb][8 * s + 6], st[kb][8 * s + 7]);
                pf[kb * 2 + s] = __builtin_bit_cast(bf16x8, w); } }
        lsum += ls;
#pragma unroll
        for (int db = 0; db < 4; ++db)
#pragma unroll
            for (int k4 = 0; k4 < 4; ++k4) { const bf16_t* vp = vs + (db * 32 + r32) * VRS + k4 * 16 + 4 * hi;
                const s16x4 a = *(const s16x4*)vp, bq = *(const s16x4*)(vp + 8);
                o[db] = MFMA32(__builtin_shufflevector(a, bq, 0, 1, 2, 3, 4, 5, 6, 7), pf[k4], o[db]); }
        if (t + 2 < nt) DA_STORE(s2);
        __syncthreads();
        st[0] = sn[0]; st[1] = sn[1];
        { const int tmp = s0; s0 = s1; s1 = s2; s2 = tmp; }
    }
#undef DA_QK
#undef DA_LOAD
#undef DA_STORE
    float* xbuf = (float*)lds;
    const float lt = lsum + __shfl_xor(lsum, 32);
    const float sc = (m ? lam : 1.0f) / lt;
    if (m) {
#pragma unroll
        for (int db = 0; db < 4; ++db)
#pragma unroll
            for (int i = 0; i < 16; ++i) xbuf[(db * 32 + crow(i, hi)) * 128 + qt * 32 + r32] = o[db][i] * sc; }
    __syncthreads();
    if (!m) { float ss = 0.f;
#pragma unroll
        for (int db = 0; db < 4; ++db)
#pragma unroll
            for (int i = 0; i < 16; ++i) { const float v = o[db][i] * sc - xbuf[(db * 32 + crow(i, hi)) * 128 + qt * 32 + r32]; o[db][i] = v; ss += v * v; }
        ss += __shfl_xor(ss, 32);
        const float rs = (1.0f / sqrtf(ss * (1.f / 128.f) + 1e-5f)) * 0.8f;
        bf16_t* op = (bf16_t*)(P.ws + WS_ABUF) + (size_t)qrow * DM + 512 + h * 128; const float* sg = P.in[I_SUBLN];
#pragma unroll
        for (int db = 0; db < 4; ++db)
#pragma unroll
            for (int g = 0; g < 4; ++g) { const int d = db * 32 + 8 * g + 4 * hi; const f32x4 gg = *(const f32x4*)(sg + d);
                u32x2 w; w.x = pk2(o[db][4 * g] * rs * gg.x, o[db][4 * g + 1] * rs * gg.y); w.y = pk2(o[db][4 * g + 2] * rs * gg.z, o[db][4 * g + 3] * rs * gg.w);
                *(u32x2*)(op + d) = w; } }
}
DI void phase_diff_attn(const Params& P, unsigned char* lds) {
    const int lane = threadIdx.x & 63;
    float lam;
    { const float a = P.in[I_LQ1][lane] * P.in[I_LK1][lane], b2 = P.in[I_LQ2][lane] * P.in[I_LK2][lane]; lam = expf(wave_sum(a)) - expf(wave_sum(b2)) + 0.2f; }
    for (int it = blockIdx.x; it < 1152; it += gridDim.x) {
        if (it < 1024) { const int qb = it & 15, h = (it >> 4) & 3, b = it >> 6; diff_attn_block(P, lds, b, h, b * TT + NCTX + qb * 128, 36, lam); }
        else { const int e = it - 1024; const int qb = e & 1, h = (e >> 1) & 3, b = e >> 3; diff_attn_block(P, lds, b, h, b * TT + qb * 128, 4, lam); }
    }
    __syncthreads();
}
DI void swa_block(const Params& P, unsigned char* lds, int b, int kvh, int i0) {
    const int tid = threadIdx.x, lane = tid & 63, wave = tid >> 6, r32 = lane & 31, hi = lane >> 5, g = wave & 3, qt = wave >> 2, hq = kvh * 4 + g;
    const bf16_t* Pb = (const bf16_t*)(P.ws + WS_BIG + BIG_P);
    constexpr int KRS = 72, VRS = 68, STG = 64 * KRS + 64 * VRS;
    bf16_t* stg = (bf16_t*)lds;
    const int qpos = i0 + qt * 32 + r32; const int qrow = b * TT + NCTX + qpos;
    bf16x8 qf[4];
    { const bf16_t* qp = Pb + (size_t)qrow * LDP1 + 1552 + hq * 64 + hi * 8;
#pragma unroll
      for (int s = 0; s < 4; ++s) qf[s] = *(const bf16x8*)(qp + s * 16); }
    f32x16 o[2]; float mref = -INFINITY, lsum = 0.f;
#pragma unroll
    for (int db = 0; db < 2; ++db)
#pragma unroll
        for (int i = 0; i < 16; ++i) o[db][i] = 0.f;
    const bf16_t* Kg = Pb + (size_t)(b * TT) * LDP1 + 1552 + 512 + kvh * 64;
    const bf16_t* Vg = (const bf16_t*)(P.ws + WS_BIG + BIG_VT1) + (size_t)((b * 2 + kvh) * 64) * TT;
    const int wlo = i0 - 128 < 0 ? 0 : i0 - 128; const int whi = i0 + 192 > LSEQ ? LSEQ : i0 + 192; const int nt = 4 + (whi - wlo) / 64;
    const int kkey = tid >> 3, kc = (tid & 7) * 8;
    u32x4 kr, vr;
#define SW_KEY0(t) ((t) < 4 ? 64 * (t) : NCTX + wlo + 64 * ((t) - 4))
#define SW_LOAD(t) do { const int k0_ = SW_KEY0(t); kr = *(const u32x4*)(Kg + (size_t)(k0_ + kkey) * LDP1 + kc); vr = *(const u32x4*)(Vg + (size_t)kkey * TT + k0_ + kc); } while (0)
#define SW_STORE(sb) do { bf16_t* ks_ = stg + (sb) * STG; *(u32x4*)(ks_ + kkey * KRS + kc) = kr; bf16_t* vs_ = ks_ + 64 * KRS; \
        *(u32x2*)(vs_ + kkey * VRS + kc) = (u32x2){vr.x, vr.y}; *(u32x2*)(vs_ + kkey * VRS + kc + 4) = (u32x2){vr.z, vr.w}; } while (0)
    __syncthreads();
    SW_LOAD(0); SW_STORE(0);
    __syncthreads();
    for (int t = 0; t < nt; ++t) {
        if (t + 1 < nt) SW_LOAD(t + 1);
        const bf16_t* ks = stg + (t & 1) * STG; const bf16_t* vs = ks + 64 * KRS;
        f32x16 st[2];
#pragma unroll
        for (int kb = 0; kb < 2; ++kb) {
#pragma unroll
            for (int i = 0; i < 16; ++i) st[kb][i] = 0.f;
#pragma unroll
            for (int s = 0; s < 4; ++s) { const bf16x8 kf = *(const bf16x8*)(ks + (kb * 32 + r32) * KRS + s * 16 + hi * 8); st[kb] = MFMA32(kf, qf[s], st[kb]); } }
        if (t >= 4) { const int kp0 = wlo + 64 * (t - 4);
#pragma unroll
            for (int kb = 0; kb < 2; ++kb)
#pragma unroll
                for (int i = 0; i < 16; ++i) { const int dlt = qpos - (kp0 + kb * 32 + crow(i, hi)); if (dlt > 128 || dlt < -128) st[kb][i] = -INFINITY; } }
        float mx = fmaxf(st[0][0], st[1][0]);
#pragma unroll
        for (int i = 1; i < 16; ++i) mx = fmaxf(mx, fmaxf(st[0][i], st[1][i]));
        mx = fmaxf(mx, __shfl_xor(mx, 32));
        if (__any((mx - mref) * C2 > 8.0f)) { const float nm = fmaxf(mref, mx); const float f = exp2f((mref - nm) * C2); lsum *= f; mref = nm;
#pragma unroll
            for (int db = 0; db < 2; ++db)
#pragma unroll
                for (int i = 0; i < 16; ++i) o[db][i] *= f; }
        const float nmc = -mref * C2; float ls = 0.f;
        bf16x8 pf[4];
#pragma unroll
        for (int kb = 0; kb < 2; ++kb) {
#pragma unroll
            for (int i = 0; i < 16; ++i) { st[kb][i] = __builtin_amdgcn_exp2f(st[kb][i] * C2 + nmc); ls += st[kb][i]; }
#pragma unroll
            for (int s = 0; s < 2; ++s) { u32x4 w; w.x = pk2(st[kb][8 * s], st[kb][8 * s + 1]); w.y = pk2(st[kb][8 * s + 2], st[kb][8 * s + 3]); w.z = pk2(st[kb][8 * s + 4], st[kb][8 * s + 5]); w.w = pk2(st[kb][8 * s + 6], st[kb][8 * s + 7]);
                pf[kb * 2 + s] = __builtin_bit_cast(bf16x8, w); } }
        lsum += ls;
#pragma unroll
        for (int db = 0; db < 2; ++db)
#pragma unroll
            for (int k4 = 0; k4 < 4; ++k4) { const bf16_t* vp = vs + (db * 32 + r32) * VRS + k4 * 16 + 4 * hi;
                const s16x4 a = *(const s16x4*)vp, bq = *(const s16x4*)(vp + 8);
                o[db] = MFMA32(__builtin_shufflevector(a, bq, 0, 1, 2, 3, 4, 5, 6, 7), pf[k4], o[db]); }
        if (t + 1 < nt) SW_STORE((t + 1) & 1);
        __syncthreads();
    }
#undef SW_KEY0
#undef SW_LOAD
#undef SW_STORE
    float l = lsum + __shfl_xor(lsum, 32);
    l += exp2f(P.in[I_SINK][hq] * LOG2E - mref * C2);
    const float il = 1.0f / l;
    bf16_t* op = (bf16_t*)(P.ws + WS_ABUF) + (size_t)qrow * DM + 512 + hq * 64;
#pragma unroll
    for (int db = 0; db < 2; ++db)
#pragma unroll
        for (int gq = 0; gq < 4; ++gq) { const int dd = db * 32 + 8 * gq + 4 * hi;
            u32x2 w; w.x = pk2(o[db][4 * gq] * il, o[db][4 * gq + 1] * il); w.y = pk2(o[db][4 * gq + 2] * il, o[db][4 * gq + 3] * il);
            *(u32x2*)(op + dd) = w; }
}
DI void phase_swa(const Params& P, unsigned char* lds) {
    for (int it = blockIdx.x; it < 1024; it += gridDim.x) { const int qb = it & 31, kvh = (it >> 5) & 1, b = it >> 6; swa_block(P, lds, b, kvh, qb * 64); }
    __syncthreads();
}

struct RwOps { f32x4 w0, w1, m0, m1, k0, k1, b0, b1, r0, r1; float vv; };
template <int d>
DI void rwkv_chain_t(const Params& P, unsigned char* lds, int chain) {
    const int tid = threadIdx.x, lane = tid & 63, wave = tid >> 6;
    const int b = chain >> 4, h = (chain >> 1) & 7;
    const bf16_t* Pb = (const bf16_t*)(P.ws + WS_BIG + BIG_P);
    constexpr int CT = 64, TWS = 72;
    float* rs = (float*)lds;
    float* ks = rs + 4096; float* vs = ks + 4096;
    float* wd = vs + 4096; float* km = wd + 4096; float* kk = km + 4096; float* bv = kk + 4096;
    bf16_t* raw = (bf16_t*)wd;
    bf16_t* yb = (bf16_t*)(bv + 4096);
    bf16_t* tw = yb + 4096;
    bf16_t* xa = tw + CT * TWS;
    float* rsq = (float*)(xa + CT * TWS);
    bf16_t* yout = (bf16_t*)(P.ws + WS_BIG + BIG_Y0) + (size_t)d * MROWS * 512;
    const int mat = wave >> 2, jl = (wave & 3) * 16 + (lane & 15), quad = lane >> 4;
    bf16x8 bw[2];
    { const float* W = (mat ? P.in[I_RA2] : P.in[I_RW2]) + (size_t)(d * 64) * 512 + h * 64 + jl;
#pragma unroll
      for (int s2 = 0; s2 < 2; ++s2) { const float* wp_ = W + (size_t)(32 * s2 + 8 * quad) * 512;
          u32x4 w; w.x = pk2(wp_[0], wp_[512]); w.y = pk2(wp_[2 * 512], wp_[3 * 512]); w.z = pk2(wp_[4 * 512], wp_[5 * 512]); w.w = pk2(wp_[6 * 512], wp_[7 * 512]);
          bw[s2] = __builtin_bit_cast(bf16x8, w); } }
    const float c0v = (mat ? P.in[I_RA0] : P.in[I_RW0])[d * 512 + h * 64 + jl], kkvj = P.in[I_RKK][h * 64 + jl], kavj = P.in[I_RKA][h * 64 + jl];
    __syncthreads();
    float* mus = rsq + CT;
    float* kks = mus + 320;
    if (tid < 320) { const int g = tid >> 6, cc = tid & 63; mus[tid] = P.in[I_MU][(g < 3 ? g * 512 + h * 64 : (g == 3 ? 1536 : 1600)) + cc]; }
    if (tid < 64) kks[tid] = P.in[I_RKK][h * 64 + tid];
    const int stt = tid >> 3, sc8 = (tid & 7) * 8;
    f32x2 S0a = {0.f, 0.f}, S0b = {0.f, 0.f}, S1a = {0.f, 0.f}, S1b = {0.f, 0.f};
    const int v0 = wave * 8 + 2 * (lane >> 4), kc = (lane & 15) * 4; const bool evn = (lane & 1) == 0;
    u32x4 rg[6];
#define RW_TLO(c) (d == 0 ? 64 * (c) : ((c) < 4 ? 192 - 64 * (c) : 2496 - 64 * (c)))
#define RW_LOAD(c) do { const int tlo_ = RW_TLO(c); const int slo_ = tlo_ < NCTX ? 0 : NCTX, shi_ = tlo_ < NCTX ? NCTX : TT; \
        _Pragma("unroll") for (int q_ = 0; q_ < 6; ++q_) { const int e_ = tid + 512 * q_; rg[q_] = (u32x4){0u, 0u, 0u, 0u}; \
            if (e_ < 66 * 40) { const int rr_ = e_ / 40, rem_ = e_ - rr_ * 40, g_ = rem_ >> 3, c8_ = rem_ & 7; const int tq_ = tlo_ - 1 + rr_; \
                const int col_ = g_ < 3 ? g_ * 512 + h * 64 : (g_ == 3 ? 1536 : 1600); \
                if (tq_ >= slo_ && tq_ < shi_) rg[q_] = *(const u32x4*)(Pb + (size_t)(b * TT + tq_) * LDP0 + col_ + c8_ * 8); } } } while (0)
    RW_LOAD(0);
    for (int c = 0; c < 36; ++c) {
        const int tlo = RW_TLO(c);
#pragma unroll
        for (int q = 0; q < 6; ++q) { const int e = tid + 512 * q; if (e < 66 * 40) { const int rr = e / 40, rem = e - rr * 40; *(u32x4*)(raw + rr * 320 + rem * 8) = rg[q]; } }
        __syncthreads();
        if (c > 0) { const int tt = tid >> 3, c8 = tid & 7; *(u32x4*)(yout + (size_t)(b * TT + RW_TLO(c - 1) + tt) * 512 + h * 64 + c8 * 8) = *(const u32x4*)(yb + tt * 64 + c8 * 8); }
#pragma unroll
        for (int g = 0; g < 5; ++g) {
            float cu[8], pv[8], nx[8], sv[8];
            unpack8(*(const u32x4*)(raw + (stt + 1) * 320 + g * 64 + sc8), cu); unpack8(*(const u32x4*)(raw + stt * 320 + g * 64 + sc8), pv); unpack8(*(const u32x4*)(raw + (stt + 2) * 320 + g * 64 + sc8), nx);
            const f32x4 m0 = *(const f32x4*)(mus + g * 64 + sc8), m1 = *(const f32x4*)(mus + g * 64 + sc8 + 4);
            const float mm[8] = {m0.x, m0.y, m0.z, m0.w, m1.x, m1.y, m1.z, m1.w};
#pragma unroll
            for (int j = 0; j < 8; ++j) sv[j] = cu[j] + mm[j] * (0.5f * (pv[j] + nx[j]) - cu[j]);
            if (g < 3) { float* dst = g == 0 ? rs : (g == 1 ? ks : vs);
                *(f32x4*)(dst + stt * 64 + sc8) = (f32x4){sv[0], sv[1], sv[2], sv[3]}; *(f32x4*)(dst + stt * 64 + sc8 + 4) = (f32x4){sv[4], sv[5], sv[6], sv[7]};
                if (g == 1) { const f32x4 k0 = *(const f32x4*)(kks + sc8), k1 = *(const f32x4*)(kks + sc8 + 4); const float kq[8] = {k0.x, k0.y, k0.z, k0.w, k1.x, k1.y, k1.z, k1.w};
                    float ssq = 0.f;
#pragma unroll
                    for (int j = 0; j < 8; ++j) { const float q_ = sv[j] * kq[j]; ssq += q_ * q_; }
                    ssq = reduce8(ssq);
                    if ((tid & 7) == 0) rsq[stt] = 1.0f / sqrtf(fmaxf(ssq, 1e-24f)); } }
            else { if (g == 3) {
#pragma unroll
                    for (int j = 0; j < 8; ++j) sv[j] = tanhf_(sv[j]); }
                u32x4 w; w.x = pk2(sv[0], sv[1]); w.y = pk2(sv[2], sv[3]); w.z = pk2(sv[4], sv[5]); w.w = pk2(sv[6], sv[7]);
                *(u32x4*)((g == 3 ? tw : xa) + stt * TWS + sc8) = w; } }
        __syncthreads();
        if (c + 1 < 36) RW_LOAD(c + 1);
        { const bf16_t* src = mat ? xa : tw;
#pragma unroll 1
          for (int th = 0; th < 4; ++th) { f32x4 acc = {c0v, c0v, c0v, c0v};
              const bf16x8 af0 = *(const bf16x8*)(src + (th * 16 + (lane & 15)) * TWS + 8 * quad), af1 = *(const bf16x8*)(src + (th * 16 + (lane & 15)) * TWS + 32 + 8 * quad);
              acc = __builtin_amdgcn_mfma_f32_16x16x32_bf16(af0, bw[0], acc, 0, 0, 0); acc = __builtin_amdgcn_mfma_f32_16x16x32_bf16(af1, bw[1], acc, 0, 0, 0);
#pragma unroll
              for (int rg_ = 0; rg_ < 4; ++rg_) { const int tt = th * 16 + quad * 4 + rg_, o_ = tt * 64 + jl;
                  if (mat == 0) { wd[o_] = __expf(-0.6065306597126334f * sigmoidf_(acc[rg_])); }
                  else { const float a_ = sigmoidf_(acc[rg_]); const float kraw = ks[o_]; const float kkn = kraw * kkvj * rsq[tt];
                      km[o_] = kraw * (1.0f + (a_ - 1.0f) * kavj); kk[o_] = kkn; bv[o_] = kkn * a_; } } } }
        __syncthreads();
        { struct { f32x4 w, m, k, b, r; f32x2 vv; } cur, nxt;
#define RW_LD(dst, tt_) do { const int o_ = (tt_) * 64 + kc; dst.w = *(const f32x4*)(wd + o_); dst.m = *(const f32x4*)(km + o_); dst.k = *(const f32x4*)(kk + o_); dst.b = *(const f32x4*)(bv + o_); \
            dst.r = *(const f32x4*)(rs + o_); dst.vv = *(const f32x2*)(vs + (tt_) * 64 + v0); } while (0)
          RW_LD(cur, d ? CT - 1 : 0);
#pragma unroll 1
          for (int q = 0; q < CT / 8; ++q) { float yk = 0.f;
#pragma unroll
              for (int j = 0; j < 8; ++j) { const int n = q * 8 + j; const int nn = n + 1 < CT ? n + 1 : CT - 1;
                  RW_LD(nxt, d ? CT - 1 - nn : nn);
                  f32x2 a0 = S0a * cur.k.xy + S0b * cur.k.zw, a1 = S1a * cur.k.xy + S1b * cur.k.zw;
                  const float sa0 = -reduce16(a0.x + a0.y), sa1 = -reduce16(a1.x + a1.y);
                  S0a = S0a * cur.w.xy + sa0 * cur.b.xy + cur.vv.x * cur.m.xy; S0b = S0b * cur.w.zw + sa0 * cur.b.zw + cur.vv.x * cur.m.zw;
                  S1a = S1a * cur.w.xy + sa1 * cur.b.xy + cur.vv.y * cur.m.xy; S1b = S1b * cur.w.zw + sa1 * cur.b.zw + cur.vv.y * cur.m.zw;
                  f32x2 y0 = S0a * cur.r.xy + S0b * cur.r.zw, y1 = S1a * cur.r.xy + S1b * cur.r.zw;
                  const float p0 = y0.x + y0.y, p1 = y1.x + y1.y;
                  const float e0 = p0 + dpp_x1(p0), e1 = p1 + dpp_x1(p1);
                  float yq = evn ? e0 : e1;
                  yq += dpp_x2(yq); yq += dpp_ror4(yq); yq += dpp_ror8(yq);
                  yk = (((lane & 15) >> 1) == j) ? yq : yk;
                  cur.w = nxt.w; cur.m = nxt.m; cur.k = nxt.k; cur.b = nxt.b; cur.r = nxt.r; cur.vv = nxt.vv; }
              { const int n = q * 8 + ((lane & 15) >> 1); const int tt = d ? CT - 1 - n : n; yb[tt * 64 + v0 + (lane & 1)] = f2bf(yk); } }
#undef RW_LD
        }
        __syncthreads();
    }
    { const int tt = tid >> 3, c8 = tid & 7; *(u32x4*)(yout + (size_t)(b * TT + RW_TLO(35) + tt) * 512 + h * 64 + c8 * 8) = *(const u32x4*)(yb + tt * 64 + c8 * 8); }
#undef RW_LOAD
#undef RW_TLO
    __syncthreads();
}
DI void rwkv_chain(const Params& P, unsigned char* lds, int chain) { if (chain & 1) rwkv_chain_t<1>(P, lds, chain); else rwkv_chain_t<0>(P, lds, chain); }
DI void phase_rwkv_finish(const Params& P, unsigned char* lds) {
    const int tid = threadIdx.x, lane = tid & 63, h = tid >> 6, r32 = lane & 31, hi = lane >> 5;
    const bf16_t* Pb = (const bf16_t*)(P.ws + WS_BIG + BIG_P);
    const bf16_t* y0 = (const bf16_t*)(P.ws + WS_BIG + BIG_Y0); const bf16_t* y1 = y0 + (size_t)MROWS * 512;
    bf16_t* sgb = (bf16_t*)lds;
    float* G = (float*)(lds + 8704);
    bf16x8 bfr[2][8];
#pragma unroll
    for (int nb = 0; nb < 2; ++nb)
#pragma unroll
        for (int s = 0; s < 8; ++s) { const float* gp = P.in[I_RG2] + (size_t)(16 * s + 8 * hi) * 512 + h * 64 + nb * 32 + r32;
            u32x4 w; w.x = pk2(gp[0], gp[512]); w.y = pk2(gp[2 * 512], gp[3 * 512]); w.z = pk2(gp[4 * 512], gp[5 * 512]); w.w = pk2(gp[6 * 512], gp[7 * 512]);
            bfr[nb][s] = __builtin_bit_cast(bf16x8, w); }
    const float mur = P.in[I_MU][tid], muk = P.in[I_MU][512 + tid], muv = P.in[I_MU][1024 + tid];
    const float rk = P.in[I_RRK][tid], gng = P.in[I_GNG][tid], gnb = P.in[I_GNB][tid];
    const int stt = tid >> 4, sc8 = (tid & 15) * 8;
    float mug[8];
#pragma unroll
    for (int j = 0; j < 8; ++j) mug[j] = P.in[I_MU][1664 + sc8 + j];
    for (int it = blockIdx.x; it < MROWS / 32; it += gridDim.x) {
        const int r0 = it * 32; const int t0 = r0 % TT; const int slo = t0 < NCTX ? 0 : NCTX, shi = t0 < NCTX ? NCTX : TT;
        __syncthreads();
        { const int t = t0 + stt; const bf16_t* p = Pb + (size_t)(r0 + stt) * LDP0 + 1664 + sc8;
          float c[8], pv[8], nx[8]; const u32x4 z = {0u, 0u, 0u, 0u};
          const bool hp_ = t - 1 >= slo, hn_ = t + 1 < shi; const u32x4 qc = *(const u32x4*)p, qp = *(const u32x4*)(hp_ ? p - LDP0 : p), qn = *(const u32x4*)(hn_ ? p + LDP0 : p);
          unpack8(qc, c); unpack8(hp_ ? qp : z, pv); unpack8(hn_ ? qn : z, nx);
          float sg[8];
#pragma unroll
          for (int j = 0; j < 8; ++j) sg[j] = sigmoidf_(c[j] + mug[j] * (0.5f * (pv[j] + nx[j]) - c[j]));
          u32x4 w; w.x = pk2(sg[0], sg[1]); w.y = pk2(sg[2], sg[3]); w.z = pk2(sg[4], sg[5]); w.w = pk2(sg[6], sg[7]);
          *(u32x4*)(sgb + stt * 136 + sc8) = w; }
        __syncthreads();
        { f32x16 acc[2]; bf16x8 afr[8];
#pragma unroll
          for (int i = 0; i < 16; ++i) { acc[0][i] = 0.f; acc[1][i] = 0.f; }
#pragma unroll
          for (int s = 0; s < 8; ++s) afr[s] = *(const bf16x8*)(sgb + r32 * 136 + 16 * s + 8 * hi);
#pragma unroll
          for (int s = 0; s < 8; ++s) { acc[0] = MFMA32(afr[s], bfr[0][s], acc[0]); acc[1] = MFMA32(afr[s], bfr[1][s], acc[1]); }
#pragma unroll
          for (int nb = 0; nb < 2; ++nb)
#pragma unroll
              for (int i = 0; i < 16; ++i) G[crow(i, hi) * 512 + h * 64 + nb * 32 + r32] = acc[nb][i]; }
        __syncthreads();
        { const bf16_t* p = Pb + (size_t)r0 * LDP0 + tid;
          float rp = 0.f, kp = 0.f, vp = 0.f;
          if (t0 - 1 >= slo) { rp = bf2f(*(p - LDP0)); kp = bf2f(*(p - LDP0 + 512)); vp = bf2f(*(p - LDP0 + 1024)); }
          float rc = bf2f(p[0]), kc_ = bf2f(p[512]), vc = bf2f(p[1024]);
#pragma unroll 4
          for (int tt = 0; tt < 32; ++tt) { const int r = r0 + tt; const bf16_t* pn = p + (size_t)(tt + 1) * LDP0;
              const bool hn = t0 + tt + 1 < shi; const bf16_t* pq = hn ? pn : p;
              float rn = bf2f(pq[0]), kn = bf2f(pq[512]), vn = bf2f(pq[1024]); if (!hn) { rn = 0.f; kn = 0.f; vn = 0.f; }
              const float r_s = rc + mur * (0.5f * (rp + rn) - rc), k_s = kc_ + muk * (0.5f * (kp + kn) - kc_), v_s = vc + muv * (0.5f * (vp + vn) - vc);
              const float bonus = wave_sum_fast(r_s * k_s * rk) * v_s;
              const float y = bf2f(y0[(size_t)r * 512 + tid]) + bf2f(y1[(size_t)r * 512 + tid]);
              const float mean = wave_sum_fast(y) * (1.f / 64.f); const float dy = y - mean; const float var = wave_sum_fast(dy * dy) * (1.f / 64.f);
              const float yn = dy * (1.0f / sqrtf(var + 64e-5f)) * gng + gnb;
              ((bf16_t*)(P.ws + WS_ABUF))[(size_t)r * DM + tid] = f2bf((yn + bonus) * G[tt * 512 + tid]);
              rp = rc; kp = kc_; vp = vc; rc = rn; kc_ = kn; vc = vn; } }
    }
    __syncthreads();
}

DI void ssd_chain(const Params& P, unsigned char* lds, int chain) {
    const int tid = threadIdx.x, lane = tid & 63, wave = tid >> 6, r32 = lane & 31, hi = lane >> 5;
    const int b = chain >> 4, h = (chain >> 1) & 7, d = chain & 1, g = h >> 2;
    const bf16_t* Pb = (const bf16_t*)(P.ws + WS_BIG + BIG_P); const bf16_t* X = (const bf16_t*)(P.ws + WS_BIG + BIG_XBC);
    bf16_t* yout = (bf16_t*)(P.ws + WS_BIG + BIG_Y1) + (size_t)d * MROWS * 512;
    constexpr int RS = 136, TS = 72;
    bf16_t* Cb = (bf16_t*)lds;
    bf16_t* Bb = Cb + 64 * RS;
    bf16_t* Hb = Bb + 64 * RS;
    bf16_t* BdT = Hb + 64 * RS;
    bf16_t* XT = BdT + 128 * TS;
    bf16_t* Yb = XT + 64 * TS;
    float* dec0 = (float*)(Yb + 64 * TS);
    const float dtb = P.in[I_DTB][d * 8 + h], aneg = -expf(P.in[I_ALOG][d * 8 + h]);
    __syncthreads();
    for (int e = tid; e < 64 * RS / 2; e += 512) ((unsigned*)Hb)[e] = 0u;
    f32x16 hacc;
#pragma unroll
    for (int i = 0; i < 16; ++i) hacc[i] = 0.f;
    const int hpb = wave >> 2, hnb = wave & 3;
#define SSD_TLO(c) (d == 0 ? 64 * (c) : ((c) < 4 ? 192 - 64 * (c) : 2496 - 64 * (c)))
    u32x4 pc0, pc1, pb0, pb1, xreg; float praw = 0.f;
#define SSD_LOAD(c) do { const size_t row0_ = (size_t)b * TT + SSD_TLO(c); \
        { const int s_ = tid >> 4, c8 = (tid & 15) * 8; const size_t r0_ = row0_ + (d ? 63 - s_ : s_), r1_ = row0_ + (d ? 31 - s_ : s_ + 32); \
          pc0 = *(const u32x4*)(X + r0_ * 1024 + 768 + g * 128 + c8); pb0 = *(const u32x4*)(X + r0_ * 1024 + 512 + g * 128 + c8); \
          pc1 = *(const u32x4*)(X + r1_ * 1024 + 768 + g * 128 + c8); pb1 = *(const u32x4*)(X + r1_ * 1024 + 512 + g * 128 + c8); } \
        { const int s_ = tid >> 3, c8 = (tid & 7) * 8; const size_t r_ = row0_ + (d ? 63 - s_ : s_); xreg = *(const u32x4*)(X + r_ * 1024 + h * 64 + c8); } \
        if (wave == 4) { const size_t r_ = row0_ + (d ? 63 - lane : lane); praw = bf2f(Pb[r_ * LDP1 + 1536 + d * 8 + h]); } } while (0)
#define SSD_SCAN(k) do { float* a_ = dec0 + (k) * 320; const float dt_ = softplusf_(praw + dtb); float cs_ = dt_ * aneg; \
        _Pragma("unroll") for (int off_ = 1; off_ < 64; off_ <<= 1) { const float u_ = __shfl_up(cs_, off_); if (lane >= off_) cs_ += u_; } \
        const float tot_ = __shfl(cs_, 63); a_[lane] = cs_; a_[64 + lane] = __expf(tot_ - cs_); a_[128 + lane] = __expf(cs_); a_[192 + lane] = dt_; if (lane == 0) a_[256] = __expf(tot_); } while (0)
    SSD_LOAD(0);
    if (wave == 4) SSD_SCAN(0);
    for (int c = 0; c < 36; ++c) {
        const int tlo = SSD_TLO(c);
        const size_t row0 = (size_t)b * TT + tlo;
        const float* acs = dec0 + (c & 1) * 320; const float* dte = acs + 64; const float* eacs = dte + 64; const float* dts = eacs + 64; const float* etot = dts + 64;
        const u32x4 xcur = xreg;
        { const int s_ = tid >> 4, c8 = (tid & 15) * 8;
          *(u32x4*)(Cb + s_ * RS + c8) = pc0; *(u32x4*)(Bb + s_ * RS + c8) = pb0; *(u32x4*)(Cb + (s_ + 32) * RS + c8) = pc1; *(u32x4*)(Bb + (s_ + 32) * RS + c8) = pb1;
        }
        __syncthreads();
        if (c + 1 < 36) SSD_LOAD(c + 1);
        { const int s_ = tid >> 3, c8 = (tid & 7) * 8; float xv[8]; unpack8(xcur, xv); const float dt = dts[s_];
#pragma unroll
          for (int j = 0; j < 8; ++j) XT[(c8 + j) * TS + s_] = f2bf(xv[j] * dt);
          const int n0 = (tid & 7) * 16; const float de = dte[s_]; float bvv[8];
#pragma unroll
          for (int q = 0; q < 2; ++q) { unpack8(*(const u32x4*)(Bb + s_ * RS + n0 + q * 8), bvv);
#pragma unroll
              for (int j = 0; j < 8; ++j) BdT[(n0 + q * 8 + j) * TS + s_] = f2bf(bvv[j] * de); } }
        __syncthreads();
        if (wave < 4 && tlo >= NCTX) { const int lb = wave >> 1, pb = wave & 1; const int l = lb * 32 + r32; const float acl = acs[l];
            bf16x8 cf[8], af[8];
#pragma unroll
            for (int ks = 0; ks < 8; ++ks) { cf[ks] = *(const bf16x8*)(Cb + l * RS + 16 * ks + 8 * hi); af[ks] = *(const bf16x8*)(Hb + (pb * 32 + r32) * RS + 16 * ks + 8 * hi); }
            f32x16 yt;
#pragma unroll
            for (int i = 0; i < 16; ++i) yt[i] = 0.f;
#pragma unroll
            for (int ks = 0; ks < 8; ++ks) yt = MFMA32(af[ks], cf[ks], yt);
            { const float el = eacs[l];
#pragma unroll
              for (int i = 0; i < 16; ++i) yt[i] *= el; }
            for (int sb = 0; sb <= lb; ++sb) { f32x16 gt;
#pragma unroll
                for (int ks = 0; ks < 8; ++ks) af[ks] = *(const bf16x8*)(Bb + (sb * 32 + r32) * RS + 16 * ks + 8 * hi);
                s16x4 xa_[2], xb_[2];
#pragma unroll
                for (int k2 = 0; k2 < 2; ++k2) { const bf16_t* xp = XT + (pb * 32 + r32) * TS + sb * 32 + 16 * k2 + 4 * hi; xa_[k2] = *(const s16x4*)xp; xb_[k2] = *(const s16x4*)(xp + 8); }
                f32x4 as4[4];
#pragma unroll
                for (int g4 = 0; g4 < 4; ++g4) as4[g4] = *(const f32x4*)(acs + sb * 32 + 8 * g4 + 4 * hi);
#pragma unroll
                for (int i = 0; i < 16; ++i) gt[i] = 0.f;
#pragma unroll
                for (int ks = 0; ks < 8; ++ks) gt = MFMA32(af[ks], cf[ks], gt);
#pragma unroll
                for (int i = 0; i < 16; ++i) { const int s_ = sb * 32 + crow(i, hi); gt[i] = (l >= s_) ? gt[i] * __expf(acl - as4[i >> 2][i & 3]) : 0.f; }
#pragma unroll
                for (int k2 = 0; k2 < 2; ++k2) { u32x4 w; w.x = pk2(gt[8 * k2], gt[8 * k2 + 1]); w.y = pk2(gt[8 * k2 + 2], gt[8 * k2 + 3]); w.z = pk2(gt[8 * k2 + 4], gt[8 * k2 + 5]); w.w = pk2(gt[8 * k2 + 6], gt[8 * k2 + 7]);
                    yt = MFMA32(__builtin_shufflevector(xa_[k2], xb_[k2], 0, 1, 2, 3, 4, 5, 6, 7), __builtin_bit_cast(bf16x8, w), yt); } }
#pragma unroll
            for (int i = 0; i < 16; ++i) Yb[l * TS + pb * 32 + crow(i, hi)] = f2bf(yt[i]); }
        if (wave == 4 && c + 1 < 36) SSD_SCAN((c + 1) & 1);
        { const float et = etot[0]; bf16x8 ha[4], hb[4];
#pragma unroll
          for (int i = 0; i < 16; ++i) hacc[i] *= et;
#pragma unroll
          for (int ks = 0; ks < 4; ++ks) { ha[ks] = *(const bf16x8*)(XT + (hpb * 32 + r32) * TS + 16 * ks + 8 * hi); hb[ks] = *(const bf16x8*)(BdT + (hnb * 32 + r32) * TS + 16 * ks + 8 * hi); }
#pragma unroll
          for (int ks = 0; ks < 4; ++ks) hacc = MFMA32(ha[ks], hb[ks], hacc); }
        __syncthreads();
#pragma unroll
        for (int i = 0; i < 16; ++i) Hb[(hpb * 32 + crow(i, hi)) * RS + hnb * 32 + r32] = f2bf(hacc[i]);
        if (tlo >= NCTX) { const int l = tid >> 3, c8 = (tid & 7) * 8; const size_t r = row0 + (d ? 63 - l : l); *(u32x4*)(yout + r * 512 + h * 64 + c8) = *(const u32x4*)(Yb + l * TS + c8); }
        __syncthreads();
    }
}
DI void phase_ssd_finish(const Params& P) {
    const int lane = threadIdx.x & 63, gw = blockIdx.x * 8 + (threadIdx.x >> 6), ngw = gridDim.x * 8;
    const bf16_t* Pb = (const bf16_t*)(P.ws + WS_BIG + BIG_P); const bf16_t* X = (const bf16_t*)(P.ws + WS_BIG + BIG_XBC);
    const bf16_t* y0 = (const bf16_t*)(P.ws + WS_BIG + BIG_Y1); const bf16_t* y1 = y0 + (size_t)MROWS * 512;
    const int c8 = lane * 8; const float dsk = P.in[I_SSDD][lane >> 3];
    const f32x4 g0 = *(const f32x4*)(P.in[I_NORMG] + c8), g1 = *(const f32x4*)(P.in[I_NORMG] + c8 + 4);
    constexpr int NR = NB * LSEQ;
#define SF_ROW(i_) ((size_t)((i_) / LSEQ) * TT + NCTX + (i_) % LSEQ)
    u32x4 nz, nx, na, nb;
    if (gw < NR) { const size_t r = SF_ROW(gw); nz = *(const u32x4*)(Pb + r * LDP1 + c8); nx = *(const u32x4*)(X + r * 1024 + c8); na = *(const u32x4*)(y0 + r * 512 + c8); nb = *(const u32x4*)(y1 + r * 512 + c8); }
    for (int i = gw; i < NR; i += ngw) { const size_t r = SF_ROW(i);
        const u32x4 zv = nz, xv = nx, av = na, bv = nb;
        if (i + ngw < NR) { const size_t rn = SF_ROW(i + ngw); nz = *(const u32x4*)(Pb + rn * LDP1 + c8); nx = *(const u32x4*)(X + rn * 1024 + c8); na = *(const u32x4*)(y0 + rn * 512 + c8); nb = *(const u32x4*)(y1 + rn * 512 + c8); }
        float z[8], x[8], ya[8], yb_[8]; unpack8(zv, z); unpack8(xv, x); unpack8(av, ya); unpack8(bv, yb_);
        float v[8]; float ss = 0.f;
#pragma unroll
        for (int j = 0; j < 8; ++j) { v[j] = (ya[j] + yb_[j] + dsk * x[j]) * siluf_(z[j]); ss += v[j] * v[j]; }
        ss += dpp_x1(ss); ss += dpp_x2(ss); ss += dpp_hm(ss); ss += dpp_rm(ss);
        { auto q2 = __builtin_amdgcn_permlane16_swap(__float_as_uint(ss), __float_as_uint(ss), false, false); ss = __uint_as_float(q2[0]) + __uint_as_float(q2[1]); }
        const float rs = 1.0f / sqrtf(ss * (1.f / 256.f) + 1e-5f);
        u32x4 o; o.x = pk2(v[0] * rs * g0.x, v[1] * rs * g0.y); o.y = pk2(v[2] * rs * g0.z, v[3] * rs * g0.w); o.z = pk2(v[4] * rs * g1.x, v[5] * rs * g1.y); o.w = pk2(v[6] * rs * g1.z, v[7] * rs * g1.w);
        *(u32x4*)((bf16_t*)(P.ws + WS_ABUF) + r * DM + c8) = o; }
#undef SF_ROW
}


#define XB_TMO      128
#define XB_XCNT(j)  (256  + 64 * (j))
#define XB_XSUB(j)  (1280 + 64 * (j))
#define XB_XGEN(j)  (2304 + 64 * (j))
#define XB_TOP      3328
#define XB_TOPGEN   3392
#define XCD_BAR_WORDS 3456
#define XB_SPIN_CAP (1u << 18)

__device__ __forceinline__ unsigned xb_ld(unsigned* p)              { return __hip_atomic_load(p, __ATOMIC_RELAXED, __HIP_MEMORY_SCOPE_AGENT); }
__device__ __forceinline__ unsigned xb_add(unsigned* p, unsigned v) { return __hip_atomic_fetch_add(p, v, __ATOMIC_RELAXED, __HIP_MEMORY_SCOPE_AGENT); }
__device__ __forceinline__ unsigned xb_xcc_id() { return (unsigned)__builtin_amdgcn_s_getreg((3 << 11) | 20) & 0xFu; }
#define XB_SPIN(cond, bar) do { unsigned _sp = 0; while (cond) { __builtin_amdgcn_s_sleep(1); \
    if ((++_sp & 255u) == 0u) { if (xb_ld(&(bar)[XB_TMO])) break; if (_sp > XB_SPIN_CAP) { atomicAdd(&(bar)[XB_TMO], 1u); break; } } } } while (0)

struct XcdBarrier {
    unsigned* bar; unsigned x;
    volatile LAS unsigned* st;
};

__device__ __forceinline__ XcdBarrier xcd_barrier_post(unsigned* bar, volatile LAS unsigned* st) {
    XcdBarrier b; b.bar = bar; b.x = xb_xcc_id(); b.st = st;
    if (threadIdx.x == 0) (void)xb_add(&bar[XB_XCNT(b.x)], 1u);
    return b;
}
__device__ __forceinline__ void xcd_barrier_complete(unsigned* bar, unsigned x, unsigned& nloc, unsigned& nx) {
    const unsigned G = gridDim.x * gridDim.y * gridDim.z;
    unsigned sum, cnt, mine, sp = 0u;
    for (;;) {
        sum = 0u; cnt = 0u; mine = 0u;
#pragma unroll
        for (unsigned j = 0; j < 16; ++j) { const unsigned c = xb_ld(&bar[XB_XCNT(j)]); sum += c; cnt += (c > 0u) ? 1u : 0u; mine = (j == x) ? c : mine; }
        if (sum == G) break;
        __builtin_amdgcn_s_sleep(1);
        if ((++sp & 255u) == 0u) { if (xb_ld(&bar[XB_TMO])) break; if (sp > XB_SPIN_CAP) { atomicAdd(&bar[XB_TMO], 1u); break; } }
    }
    nloc = mine > 0u ? mine : 1u; nx = cnt > 0u ? cnt : 1u;
}

__device__ __forceinline__ void xcd_barrier(const XcdBarrier& b) {
    asm volatile("s_waitcnt vmcnt(0)" ::: "memory");
    __syncthreads();
    if (threadIdx.x == 0) {
        unsigned* bar = b.bar;
        __builtin_amdgcn_s_waitcnt(0);
        unsigned nloc = b.st[0], nx = b.st[1];
        if (nloc == 0u) { xcd_barrier_complete(bar, b.x, nloc, nx); b.st[0] = nloc; b.st[1] = nx; }
        const unsigned old = xb_add(&bar[XB_XSUB(b.x)], 1u);
        const unsigned gen = old / nloc;
        if (old + 1u == (gen + 1u) * nloc) {
            __builtin_amdgcn_fence(__ATOMIC_RELEASE, "agent");
            asm volatile("s_waitcnt vmcnt(0)" ::: "memory");
            const unsigned og = xb_add(&bar[XB_TOP], 1u);
            const unsigned tg = og / nx;
            if (og + 1u == (tg + 1u) * nx) xb_add(&bar[XB_TOPGEN], 1u);
            else XB_SPIN(xb_ld(&bar[XB_TOPGEN]) == tg, bar);
            __builtin_amdgcn_fence(__ATOMIC_ACQUIRE, "agent");
            xb_add(&bar[XB_XGEN(b.x)], 1u);
            asm volatile("s_waitcnt vmcnt(0)" ::: "memory");
        } else {
            XB_SPIN(xb_ld(&bar[XB_XGEN(b.x)]) == gen, bar);
            __builtin_amdgcn_fence(__ATOMIC_ACQUIRE, "agent");
            asm volatile("s_waitcnt vmcnt(0)" ::: "memory");
        }
    }
    __syncthreads();
}

template <class Epi>
DI void run_gemm(unsigned char* lds, const bf16_t* A, const bf16_t* Bt, int N, int K, bool latonly, const Epi& E) {
    MyOrder S; S.init(latonly ? 128 : 144, N / 256, gridDim.x, blockIdx.x, latonly ? 1 : 0);
    pg8::Gemm g; g.A = A; g.Bt = Bt; g.M = MROWS; g.N = N; g.K = K; g.ld = K;
    pg8::gemm_phase<Epi, MyOrder, false>((PG8_LAS unsigned char*)lds, g, S, E, nullptr);
}
DI EpiResid2 make_resid2(const Params& P, int layer, int gate_off, int layer0, const bf16_t* zsrc, bf16_t* zdst, int g_idx, int b_idx, int layer_ln) {
    EpiResid2 e; e.xin = P.in[I_X]; e.ctxin = P.in[I_CTX]; e.zsrc = zsrc; e.zdst = zdst; e.stats = (const float*)(P.ws + WS_HCTX);
    e.lng = P.in[g_idx] + layer_ln * 1024; e.lnb = P.in[b_idx] + layer_ln * 1024; e.modv = (const float*)(P.ws + WS_MOD) + (size_t)layer * 17 * 6144; e.gate_off = gate_off; e.layer0 = layer0; return e;
}

__global__ void __launch_bounds__(512) mega(Params P) {
    extern __shared__ __attribute__((aligned(16))) unsigned char lds[];
    cg::grid_group grid = cg::this_grid();
    volatile LAS unsigned* xst = (volatile LAS unsigned*)(lds + 147456);
    if (threadIdx.x == 0) { xst[0] = 0u; xst[1] = 0u; }
    __syncthreads();
    XcdBarrier xb = xcd_barrier_post((unsigned*)(P.ws + WS_BAR), xst);
    bf16_t* ABUF = (bf16_t*)(P.ws + WS_ABUF); bf16_t* PB = (bf16_t*)(P.ws + WS_BIG + BIG_P); bf16_t* ZB0 = (bf16_t*)P.out; bf16_t* ZB1 = (bf16_t*)(P.ws + WS_BIG + BIG_Z1);
#define PHASE(k) if (P.ph_lo <= (k) && (k) < P.ph_hi)
#define PSYNC(k) do { if ((k) > P.ph_lo) { if (P.ph_lo < 0) grid.sync();   xcd_barrier(xb); } } while (0)
#if !defined(ONLY) || ONLY == 0
    PHASE(0) { PSYNC(0); REP(0) phase_prep(P, lds); }
#endif
#if !defined(ONLY) || ONLY == 1
    if ((REP_MASK >> 26) & 1u) { for (int q_ = 0; q_ < 16; ++q_) xcd_barrier(xb); }
    PHASE(1) { PSYNC(1); REP(1) phase_rows<0>(P, nullptr, 0, 0, 0, 0, 0, false); }
#endif
#if !defined(ONLY) || ONLY == 2
    PHASE(2) { PSYNC(2); REP(2) { EpiB16<0> e; e.O = PB; e.ldc = LDP0; run_gemm(lds, ABUF, (const bf16_t*)(P.ws + WS_WAB), 3328, 1024, false, e); } }
#endif
#if !defined(ONLY) || ONLY == 3
    PHASE(3) { PSYNC(3); REP(19) for (int ch = blockIdx.x; ch < 256; ch += gridDim.x) rwkv_chain(P, lds, ch);
                phase_rope(PB, LDP0, 1792, 16); REP(24) phase_vt<128>(PB, LDP0, 1792 + 1024, 4, (bf16_t*)(P.ws + WS_BIG + BIG_VT0), lds); }
#endif
#if !defined(ONLY) || ONLY == 4
    PHASE(4) { PSYNC(4); REP(20) phase_diff_attn(P, lds); REP(21) phase_rwkv_finish(P, lds); }
#endif
#if !defined(ONLY) || ONLY == 5
    PHASE(5) { PSYNC(5); REP(5) { EpiResid2 e = make_resid2(P, 0, 2 * 1024, 1, ZB0, ZB0, I_LNMG, I_LNMB, 0); run_gemm(lds, ABUF, (const bf16_t*)(P.ws + WS_WOUT), 1024, 1024, false, e); } }
#endif
#if !defined(ONLY) || ONLY == 6
    PHASE(6) { PSYNC(6); phase_rows<1>(P, ZB0, 0, I_LNMG, I_LNMB, 0, 3 * 1024, false); }
#endif
#if !defined(ONLY) || ONLY == 7
    PHASE(7) { PSYNC(7); REP(7) { EpiB16<1> e; e.O = PB; e.ldc = 4096; run_gemm(lds, ABUF, (const bf16_t*)(P.ws + WS_W1), 4096, 1024, false, e); } }
#endif
#if !defined(ONLY) || ONLY == 8
    PHASE(8) { PSYNC(8); { EpiResid2 e = make_resid2(P, 0, 5 * 1024, 0, ZB0, ZB0, I_LNMG, I_LNMB, 0); run_gemm(lds, PB, (const bf16_t*)(P.ws + WS_W2), 1024, 4096, true, e); }
                 { EpiPart e2; e2.slab = (float*)ZB1; CtxSplitOrder S2; S2.G = gridDim.x; S2.c = blockIdx.x; pg8::Gemm g2; g2.A = PB; g2.Bt = (const bf16_t*)(P.ws + WS_W2); g2.M = MROWS; g2.N = 1024; g2.K = 1024; g2.ld = 4096;
                   pg8::gemm_phase<EpiPart, CtxSplitOrder, false>((PG8_LAS unsigned char*)lds, g2, S2, e2, nullptr); } }
#endif
#if !defined(ONLY) || ONLY == 9
    PHASE(9) { PSYNC(9); phase_rows<1>(P, ZB0, 0, I_LNFG, I_LNFB, 1, 0, true); phase_rows_ctx(P, ZB0, (const float*)ZB1); }
#endif
#if !defined(ONLY) || ONLY == 10
    PHASE(10) { PSYNC(10); REP(10) { EpiB16<0> e; e.O = PB; e.ldc = LDP1; run_gemm(lds, ABUF, (const bf16_t*)(P.ws + WS_WCD), 2560, 1024, false, e); } }
#endif
#if !defined(ONLY) || ONLY == 11
    PHASE(11) { PSYNC(11); REP(11) phase_conv(P); phase_rope(PB, LDP1, 1552, 10); REP(25) phase_vt<64>(PB, LDP1, 1552 + 512 + 128, 2, (bf16_t*)(P.ws + WS_BIG + BIG_VT1), lds); }
#endif
#if !defined(ONLY) || ONLY == 12
    PHASE(12) { PSYNC(12); REP(22) for (int ch = blockIdx.x; ch < 256; ch += gridDim.x) ssd_chain(P, lds, ch);
                 REP(23) phase_swa(P, lds); }
#endif
#if !defined(ONLY) || ONLY == 13
    PHASE(13) { PSYNC(13); REP(13) phase_ssd_finish(P); }
#endif
#if !defined(ONLY) || ONLY == 14
    PHASE(14) { PSYNC(14); { EpiResid2 e = make_resid2(P, 1, 2 * 1024, 0, ZB0, ZB0, I_LNFG, I_LNFB, 0); run_gemm(lds, ABUF, (const bf16_t*)(P.ws + WS_WOUT) + (size_t)1024 * 1024, 1024, 1024, true, e); } }
#endif
#if !defined(ONLY) || ONLY == 15
    PHASE(15) { PSYNC(15); phase_rows<1>(P, ZB0, 1, I_LNMG, I_LNMB, 1, 3 * 1024, true); }
#endif
#if !defined(ONLY) || ONLY == 16
    PHASE(16) { PSYNC(16); REP(16) { EpiB16<1> e; e.O = PB; e.ldc = 4096; run_gemm(lds, ABUF, (const bf16_t*)(P.ws + WS_W1) + (size_t)4096 * 1024, 4096, 1024, true, e); } }
#endif
#if !defined(ONLY) || ONLY == 17
    PHASE(17) { PSYNC(17); { EpiResid2 e = make_resid2(P, 1, 5 * 1024, 0, ZB0, ZB1, I_LNMG, I_LNMB, 1); run_gemm(lds, PB, (const bf16_t*)(P.ws + WS_W2) + (size_t)4096 * 1024, 1024, 4096, true, e); } }
#endif
#if !defined(ONLY) || ONLY == 18
    PHASE(18) { PSYNC(18); phase_rows<2>(P, ZB1, 1, I_LNFG, I_LNFB, 0, 0, true); }
#endif
}

#ifndef COOP
#define COOP 1
#endif
extern "C" void kernel_launch(void* const* d_in, const int* in_sizes, int n_in, void* d_out, int out_size, void* d_ws, size_t ws_size, hipStream_t stream) {
    static int grid = 0;
    if (grid == 0) {
        if (n_in != 38 || ws_size < WS_NEED) { fprintf(stderr, "kernel_launch: n_in %d ws %zu need %zu\n", n_in, ws_size, (size_t)WS_NEED); grid = -1; return; }
        int dev = 0, cus = 0, per_cu = 0;
        hipGetDevice(&dev); hipDeviceGetAttribute(&cus, hipDeviceAttributeMultiprocessorCount, dev);
        if (hipFuncSetAttribute((const void*)mega, hipFuncAttributeMaxDynamicSharedMemorySize, LDS_BYTES) != hipSuccess) { fprintf(stderr, "hipFuncSetAttribute failed\n"); grid = -1; return; }
        hipOccupancyMaxActiveBlocksPerMultiprocessor(&per_cu, (const void*)mega, 512, LDS_BYTES);
        (void)hipGetLastError();
        if (per_cu < 1) per_cu = 1;
        grid = cus * 1;
    }
    if (grid < 0) return;
    if (hipMemsetAsync((char*)d_ws + WS_BAR, 0, XCD_BAR_WORDS * 4, stream) != hipSuccess) { fprintf(stderr, "memset failed\n"); return; }
    Params p{};
    for (int i = 0; i < 38; ++i) p.in[i] = (const float*)d_in[i];
    p.out = (float*)d_out; p.ws = (unsigned char*)d_ws;
#if COOP
    p.ph_lo = 0; p.ph_hi = NPH;
    void* args[] = {&p};
    hipError_t e = hipLaunchCooperativeKernel((const void*)mega, dim3(grid), dim3(512), args, LDS_BYTES, stream);
    if (e != hipSuccess) fprintf(stderr, "cooperative launch failed: %s (grid %d)\n", hipGetErrorString(e), grid);
#else
    for (int ph = 0; ph < NPH; ++ph) { p.ph_lo = ph; p.ph_hi = ph + 1; hipLaunchKernelGGL(mega, dim3(grid), dim3(512), LDS_BYTES, stream, p); }
#endif
}
```

```cpp
#include <hip/hip_runtime.h>
#include <hip/hip_cooperative_groups.h>
#include <cstdio>
#include <cstdint>
namespace cg = cooperative_groups;
namespace pg8 {
#define PG8_LAS __attribute__((address_space(3)))
typedef unsigned short bf16_t;
typedef short bf16x8 __attribute__((ext_vector_type(8)));
typedef float f32x4 __attribute__((ext_vector_type(4)));
typedef unsigned u32x4 __attribute__((ext_vector_type(4)));
constexpr int BM = 256, BK = 64, HALF = 128, HTB = HALF * BK * 2  , STAGE_BYTES = 8 * HTB, NXCD = 8, WGM = 8;

__host__ __device__ __forceinline__ int lds_byte(int r, int c) { const int st = (r >> 4) * 2 + (c >> 5), rr = r & 15, cc = c & 31, ob = rr * 64 + cc * 2; return st * 1024 + (ob ^ (((ob >> 9) & 1) << 5)); }
__host__ __device__ __forceinline__ void stage_rc(int b, int& R, int& C) { const int st = b / 1024, sb = b % 1024, swz = sb ^ (((sb >> 9) & 1) << 5); R = (st >> 1) * 16 + swz / 64; C = (st & 1) * 32 + (swz % 64) / 2; }
__host__ __device__ __forceinline__ int perm32(int rho) { const int n = rho >> 4, i = rho & 15; return 8 * (i >> 2) + 4 * n + (i & 3); }

struct Unit { int pm, pn, kq; };
struct Gemm { const bf16_t* A; const bf16_t* Bt; int M, N, K, ld; };

__device__ __forceinline__ unsigned cvt_pk_bf16(float lo, float hi) { unsigned r; asm volatile("v_cvt_pk_bf16_f32 %0, %1, %2" : "=v"(r) : "v"(lo), "v"(hi)); return r; }
template <class Epi, class Sched, bool STAMP = false>
__device__ __forceinline__ void gemm_phase(PG8_LAS unsigned char* lds, const Gemm g, const Sched& S, const Epi& E, unsigned long long* stamps) {
    const int tid = threadIdx.x, wid = __builtin_amdgcn_readfirstlane(tid >> 6), lane = tid & 63, wr = wid >> 2, wc = wid & 3, fr = lane & 15, fq = lane >> 4;
    const int K = g.ld, nt = g.K / BK;
    int ts_lo = 0, ts_hi = 0, nts = 0; const unsigned long long rt_entry = STAMP ? (unsigned long long)wall_clock64() : 0ull;
#define PG8_STAMP() do { if (STAMP && wid == 0 && nts < 64) { const unsigned long long _c = (unsigned long long)clock64(); \
        ts_lo = (lane == nts) ? (int)(unsigned)_c : ts_lo; ts_hi = (lane == nts) ? (int)(unsigned)(_c >> 32) : ts_hi; ++nts; } } while (0)
    PG8_STAMP();
    unsigned voffA[2], voffB[2];
#pragma unroll
    for (int i = 0; i < 2; ++i) { int R, C; stage_rc(tid * 16 + i * 8192, R, C); const int Rb = Epi::PERM ? ((R & ~31) + perm32(R & 31)) : R;
        voffA[i] = (unsigned)(R * K + C) * 2u; voffB[i] = (unsigned)(Rb * K + C) * 2u; }
    const size_t kstep = (size_t)(BK * 2);
    const size_t hstep = (size_t)HALF * K * 2;
    const size_t tstep = 2 * hstep;
    const unsigned ldsw = (unsigned)wid * 1024u;
    const int aoff = lds_byte(wr * 64 + fr, fq * 8), boff = lds_byte(wc * 32 + fr, fq * 8);
#define PG8_SA(b, h) (((b) * 2 + (h)) * HTB)
#define PG8_SB(b, h) ((4 + (b) * 2 + (h)) * HTB)
#define PG8_STAGE(bufoff, gbase, voff) do { _Pragma("unroll") for (int _i = 0; _i < 2; ++_i) \
        __builtin_amdgcn_global_load_lds((const unsigned*)((const char*)(gbase) + (voff)[_i]), (PG8_LAS unsigned*)(lds + (bufoff) + ldsw + _i * 8192), 16, 0, 0); } while (0)
#define PG8_LDA(dst, b, h) do { _Pragma("unroll") for (int m = 0; m < 4; ++m) _Pragma("unroll") for (int k = 0; k < 2; ++k) dst[m][k] = *(const PG8_LAS bf16x8*)(lds + PG8_SA(b, h) + aoff + m * 2048 + k * 1024); } while (0)
#define PG8_LDB(dst, b, h) do { _Pragma("unroll") for (int n = 0; n < 2; ++n) _Pragma("unroll") for (int k = 0; k < 2; ++k) dst[n][k] = *(const PG8_LAS bf16x8*)(lds + PG8_SB(b, h) + boff + n * 2048 + k * 1024); } while (0)
#define PG8_MMA(ai, bj, At, Bt) do { __builtin_amdgcn_s_setprio(1); _Pragma("unroll") for (int m = 0; m < 4; ++m) _Pragma("unroll") for (int n = 0; n < 2; ++n) _Pragma("unroll") for (int k = 0; k < 2; ++k) \
        acc[ai][bj][m][n] = __builtin_amdgcn_mfma_f32_16x16x32_bf16(Bt[n][k], At[m][k], acc[ai][bj][m][n], 0, 0, 0); __builtin_amdgcn_s_setprio(0); } while (0)
#define PG8_WAIT_V(n) asm volatile("s_waitcnt vmcnt(" #n ")" ::: "memory")
#define PG8_WAIT_L(n) asm volatile("s_waitcnt lgkmcnt(" #n ")" ::: "memory")
#define PG8_BAR __builtin_amdgcn_s_barrier()
#define PG8_SCHED __builtin_amdgcn_sched_barrier(0)
    Unit cur, nxt; int ui = 0;
    if (!S.next(0, cur)) return;
    f32x4 acc[2][2][4][2];
#pragma unroll
    for (int a = 0; a < 2; ++a)
#pragma unroll
        for (int b = 0; b < 2; ++b)
#pragma unroll
            for (int m = 0; m < 4; ++m)
#pragma unroll
                for (int n = 0; n < 2; ++n) acc[a][b][m][n] = (f32x4){0.f, 0.f, 0.f, 0.f};
    bf16x8 At[4][2], B0[2][2], B1[2][2];
    const size_t kqb = (size_t)g.K * 2;
    const char* cA = (const char*)g.A + (size_t)cur.pm * tstep + cur.kq * kqb; const char* cB = (const char*)g.Bt + (size_t)cur.pn * tstep + cur.kq * kqb;
    S.a_ready(cur);
    PG8_STAGE(PG8_SB(0, 0), cB, voffB); PG8_STAGE(PG8_SA(0, 0), cA, voffA); PG8_STAGE(PG8_SB(0, 1), cB + hstep, voffB); PG8_STAGE(PG8_SA(0, 1), cA + hstep, voffA);
    if (wr == 1) PG8_BAR;
    PG8_WAIT_V(4); PG8_BAR;
    PG8_STAGE(PG8_SB(1, 0), cB + kstep, voffB); PG8_STAGE(PG8_SA(1, 0), cA + kstep, voffA); PG8_STAGE(PG8_SB(1, 1), cB + hstep + kstep, voffB);
    PG8_WAIT_V(6); PG8_BAR;
    PG8_STAMP();
    for (;;) {
        const bool has_next = S.next(ui + 1, nxt);
        const char* nA = has_next ? (const char*)g.A + (size_t)nxt.pm * tstep + nxt.kq * kqb : cA; const char* nB = has_next ? (const char*)g.Bt + (size_t)nxt.pn * tstep + nxt.kq * kqb : cB;
        for (int t = 0; t < nt; t += 2) {
            const bool last = (t == nt - 2);
            const char* a1 = cA + (size_t)(t + 1) * kstep;
            const char* a2 = last ? nA : cA + (size_t)(t + 2) * kstep; const char* b2 = last ? nB : cB + (size_t)(t + 2) * kstep;
            const char* a3 = a2 + kstep; const char* b3 = b2 + kstep;
            if (last && has_next) S.a_ready(nxt);
            PG8_LDB(B0, 0, 0); PG8_SCHED; PG8_LDA(At, 0, 0); PG8_STAGE(PG8_SA(1, 1), a1 + hstep, voffA);
            PG8_WAIT_L(8); PG8_BAR; PG8_WAIT_L(0); PG8_MMA(0, 0, At, B0); PG8_BAR; PG8_SCHED;
            PG8_LDB(B1, 0, 1); PG8_STAGE(PG8_SB(0, 0), b2, voffB);
            PG8_BAR; PG8_WAIT_L(0); PG8_MMA(0, 1, At, B1); PG8_BAR;
            PG8_LDA(At, 0, 1); PG8_STAGE(PG8_SA(0, 0), a2, voffA);
            PG8_BAR; PG8_WAIT_L(0); PG8_MMA(1, 0, At, B0); PG8_BAR; PG8_SCHED;
            PG8_STAGE(PG8_SB(0, 1), b2 + hstep, voffB);
            PG8_WAIT_V(6); PG8_BAR; PG8_MMA(1, 1, At, B1); PG8_BAR;
            PG8_LDB(B0, 1, 0); PG8_SCHED; PG8_LDA(At, 1, 0); PG8_STAGE(PG8_SA(0, 1), a2 + hstep, voffA);
            PG8_WAIT_L(8); PG8_BAR; PG8_WAIT_L(0); PG8_MMA(0, 0, At, B0); PG8_BAR; PG8_SCHED;
            PG8_LDB(B1, 1, 1); PG8_STAGE(PG8_SB(1, 0), b3, voffB);
            PG8_BAR; PG8_WAIT_L(0); PG8_MMA(0, 1, At, B1); PG8_BAR;
            PG8_LDA(At, 1, 1); PG8_STAGE(PG8_SA(1, 0), a3, voffA);
            PG8_BAR; PG8_WAIT_L(0); PG8_MMA(1, 0, At, B0); PG8_BAR; PG8_SCHED;
            PG8_STAGE(PG8_SB(1, 1), b3 + hstep, voffB);
            PG8_WAIT_V(6); PG8_BAR; PG8_MMA(1, 1, At, B1); PG8_BAR;
        }
        PG8_STAMP();
        if constexpr (!Epi::AFTER_DRAIN) { E(acc, cur, wr, wc, fr, fq); S.done(cur); }
        PG8_STAMP();
        if (!has_next) break;
#pragma unroll
        for (int a = 0; a < 2; ++a)
#pragma unroll
            for (int b = 0; b < 2; ++b)
#pragma unroll
                for (int m = 0; m < 4; ++m)
#pragma unroll
                    for (int n = 0; n < 2; ++n) acc[a][b][m][n] = (f32x4){0.f, 0.f, 0.f, 0.f};
        cur = nxt; cA = nA; cB = nB; ++ui;
    }
    PG8_WAIT_V(0);
    if (wr == 0) PG8_BAR;
    PG8_BAR;
    if constexpr (Epi::AFTER_DRAIN) { E.fused(acc, cur, wr, wc, fr, fq, lds, wid, lane); S.done(cur); }
    PG8_STAMP();
    if (STAMP && wid == 0) { stamps[lane] = lane < nts ? (((unsigned long long)(unsigned)ts_hi << 32) | (unsigned)ts_lo) : 0ull;
        if (lane == 62) stamps[62] = rt_entry; if (lane == 63) stamps[63] = (unsigned long long)wall_clock64(); }
#undef PG8_STAMP
#undef PG8_SA
#undef PG8_SB
#undef PG8_STAGE
#undef PG8_LDA
#undef PG8_LDB
#undef PG8_MMA
#undef PG8_WAIT_V
#undef PG8_WAIT_L
#undef PG8_BAR
#undef PG8_SCHED
}
}

using pg8::bf16_t; using pg8::bf16x8; using pg8::f32x4; using pg8::u32x4;
typedef float f32x16 __attribute__((ext_vector_type(16)));
typedef float f32x2 __attribute__((ext_vector_type(2)));
typedef __bf16 bf16v2 __attribute__((ext_vector_type(2)));
typedef short s16x4 __attribute__((ext_vector_type(4)));
typedef unsigned u32x2 __attribute__((ext_vector_type(2)));
#define DI __device__ __forceinline__
#define LAS __attribute__((address_space(3)))

constexpr int NB = 16, LSEQ = 2048, NCTX = 256, TT = 2304, MROWS = NB * TT, DM = 1024;
constexpr int LDP0 = 3328, LDP1 = 2560, NCD = 2320;
constexpr float ALPHA = 1.41421356237f;
constexpr float LOG2E = 1.4426950408889634f;
constexpr float C2 = 0.125f * LOG2E;
constexpr int LDS_BYTES = 147456 + 16;
constexpr int NPH = 19;
#ifndef REP_MASK
#define REP_MASK 0u
#endif
#define REP(bit) for (int rep_ = 0; rep_ < (((REP_MASK >> (bit)) & 1u) ? 2 : 1); ++rep_)

constexpr size_t WS_MOD = 0;
constexpr size_t WS_BAR = 0xD0000;
constexpr size_t WS_WAB = 1u << 20;
constexpr size_t WS_WCD = WS_WAB + (size_t)3328 * 1024 * 2;
constexpr size_t WS_WOUT = WS_WCD + (size_t)2560 * 1024 * 2;
constexpr size_t WS_W1 = WS_WOUT + (size_t)2 * 1024 * 1024 * 2;
constexpr size_t WS_W2 = WS_W1 + (size_t)2 * 4096 * 1024 * 2;
constexpr size_t WS_ABUF = WS_W2 + (size_t)2 * 4096 * 1024 * 2;
constexpr size_t WS_HCTX = WS_ABUF + (size_t)MROWS * 1024 * 2;
constexpr size_t WS_BIG = WS_HCTX + (size_t)4096 * 1024 * 4;
constexpr size_t BIG_P = 0;
constexpr size_t BIG_VT0 = (size_t)MROWS * 3328 * 2;
constexpr size_t BIG_Y0 = BIG_VT0 + (size_t)16 * 4 * 128 * 2304 * 2;
constexpr size_t BIG_END0 = BIG_Y0 + (size_t)2 * MROWS * 512 * 2;
constexpr size_t BIG_XBC = (size_t)MROWS * 2560 * 2;
constexpr size_t BIG_VT1 = BIG_XBC + (size_t)MROWS * 1024 * 2;
constexpr size_t BIG_Y1 = BIG_VT1 + (size_t)16 * 2 * 64 * 2304 * 2;
constexpr size_t BIG_END1 = BIG_Y1 + (size_t)2 * MROWS * 512 * 2;
constexpr size_t BIG_Z1 = (size_t)MROWS * 4096 * 2;
constexpr size_t BIG_ENDU = BIG_Z1 + (size_t)MROWS * 1024 * 2;
constexpr size_t BIG_MAX = BIG_END0 > BIG_ENDU ? (BIG_END0 > BIG_END1 ? BIG_END0 : BIG_END1) : (BIG_ENDU > BIG_END1 ? BIG_ENDU : BIG_END1);
constexpr size_t WS_NEED = WS_BIG + BIG_MAX;

struct Params {
    const float* in[38];
    float* out;
    unsigned char* ws;
    int ph_lo, ph_hi;
};
enum { I_X = 0, I_C, I_CTX, I_CCTX, I_MODW, I_MODB, I_LNMG, I_LNMB, I_LNFG, I_LNFB, I_W1, I_W2, I_WOUT, I_ABW, I_MU, I_RW0, I_RW2, I_RA0, I_RA2, I_RG2, I_RKK, I_RKA, I_RRK, I_GNG, I_GNB,
       I_LQ1, I_LK1, I_LQ2, I_LK2, I_SUBLN, I_CDW, I_CONVW, I_CONVB, I_DTB, I_ALOG, I_SSDD, I_NORMG, I_SINK };

DI float bf2f(bf16_t v) { return __uint_as_float(((unsigned)v) << 16); }
DI unsigned pk2(float a, float b) { f32x2 v = {a, b}; bf16v2 r = __builtin_convertvector(v, bf16v2); return __builtin_bit_cast(unsigned, r); }
DI bf16_t f2bf(float a) { return (bf16_t)(pk2(a, 0.f) & 0xffffu); }
DI float lo2f(unsigned u) { return __uint_as_float(u << 16); }
DI float hi2f(unsigned u) { return __uint_as_float(u & 0xffff0000u); }
typedef _Float16 f16v2 __attribute__((ext_vector_type(2)));
DI unsigned pkh2(float a, float b) { f32x2 v = {a, b}; f16v2 r = __builtin_convertvector(v, f16v2); return __builtin_bit_cast(unsigned, r); }
DI f32x2 uph2(unsigned u) { const f16v2 h = __builtin_bit_cast(f16v2, u); return __builtin_convertvector(h, f32x2); }
DI float sigmoidf_(float x) { return 1.0f / (1.0f + __expf(-x)); }
DI float siluf_(float x) { return x * sigmoidf_(x); }
DI float softplusf_(float x) { return fmaxf(x, 0.f) + __logf(1.0f + __expf(-fabsf(x))); }
DI float tanhf_(float x) { const float e = __expf(2.0f * x); return 1.0f - 2.0f / (1.0f + e); }
DI float wave_sum(float v) {
#pragma unroll
    for (int o = 1; o < 64; o <<= 1) v += __shfl_xor(v, o);
    return v;
}
DI float dpp_x1(float v) { return __int_as_float(__builtin_amdgcn_update_dpp(0, __float_as_int(v), 0xB1, 0xF, 0xF, true)); }
DI float dpp_x2(float v) { return __int_as_float(__builtin_amdgcn_update_dpp(0, __float_as_int(v), 0x4E, 0xF, 0xF, true)); }
DI float dpp_hm(float v) { return __int_as_float(__builtin_amdgcn_update_dpp(0, __float_as_int(v), 0x141, 0xF, 0xF, true)); }
DI float dpp_rm(float v) { return __int_as_float(__builtin_amdgcn_update_dpp(0, __float_as_int(v), 0x140, 0xF, 0xF, true)); }
DI float wave_sum_fast(float v) {
    v += dpp_x1(v); v += dpp_x2(v); v += dpp_hm(v); v += dpp_rm(v);
    { auto r = __builtin_amdgcn_permlane16_swap(__float_as_uint(v), __float_as_uint(v), false, false); v = __uint_as_float(r[0]) + __uint_as_float(r[1]); }
    { auto r = __builtin_amdgcn_permlane32_swap(__float_as_uint(v), __float_as_uint(v), false, false); v = __uint_as_float(r[0]) + __uint_as_float(r[1]); }
    return v;
}
DI void unpack8(const u32x4 v, float (&f)[8]) { f[0] = lo2f(v.x); f[1] = hi2f(v.x); f[2] = lo2f(v.y); f[3] = hi2f(v.y); f[4] = lo2f(v.z); f[5] = hi2f(v.z); f[6] = lo2f(v.w); f[7] = hi2f(v.w); }
DI float dpp_ror4(float v) { return __int_as_float(__builtin_amdgcn_update_dpp(0, __float_as_int(v), 0x124, 0xF, 0xF, true)); }
DI float dpp_ror8(float v) { return __int_as_float(__builtin_amdgcn_update_dpp(0, __float_as_int(v), 0x128, 0xF, 0xF, true)); }
DI float reduce16(float v) { v += dpp_x1(v); v += dpp_x2(v); v += dpp_ror4(v); v += dpp_ror8(v); return v; }
DI float reduce8(float v) { v += dpp_x1(v); v += dpp_x2(v); v += dpp_hm(v); return v; }
DI int crow(int r, int hi) { return (r & 3) + 8 * (r >> 2) + 4 * hi; }
#define MFMA32(a, b, c) __builtin_amdgcn_mfma_f32_32x32x16_bf16((a), (b), (c), 0, 0, 0)

DI float* hrow_ptr(const Params& P, int r) {
    const int b = r / TT, t = r - b * TT;
    return t < NCTX ? (float*)(P.ws + WS_HCTX) + ((size_t)b * NCTX + t) * DM : P.out + ((size_t)b * LSEQ + (t - NCTX)) * DM;
}
DI const float* h0row_ptr(const Params& P, int r) {
    const int b = r / TT, t = r - b * TT;
    return t < NCTX ? P.in[I_CTX] + ((size_t)b * NCTX + t) * DM : P.in[I_X] + ((size_t)b * LSEQ + (t - NCTX)) * DM;
}
DI const float* modrow_ptr(const Params& P, int layer, int r) {
    const int b = r / TT, t = r - b * TT;
    return (const float*)(P.ws + WS_MOD) + ((size_t)layer * 17 + (t < NCTX ? 16 : b)) * 6144;
}

struct MyOrder {
    int nM, nN, nwg, G, c, latonly;
    DI void init(int nM_, int nN_, int G_, int c_, int latonly_) { nM = nM_; nN = nN_; nwg = nM * nN; G = G_; c = c_; latonly = latonly_; }
    DI bool next(int i, pg8::Unit& u) const {
        const long L = (long)i * G + c; if (L >= nwg) return false;
        int wgid = (int)L; { const int q = nwg / pg8::NXCD, r = nwg % pg8::NXCD, xcd = wgid % pg8::NXCD, off = wgid / pg8::NXCD; wgid = (xcd < r ? xcd * (q + 1) : r * (q + 1) + (xcd - r) * q) + off; }
        const int nig = pg8::WGM * nN, gid = wgid / nig, fm = gid * pg8::WGM, gsz = (nM - fm) < pg8::WGM ? (nM - fm) : pg8::WGM;
        int pm = fm + ((wgid % nig) % gsz); u.pn = (wgid % nig) / gsz;
        if (latonly) pm = (pm >> 3) * 9 + 1 + (pm & 7);
        u.pm = pm; u.kq = 0; return true;
    }
    DI void a_ready(const pg8::Unit&) const {}
    DI void done(const pg8::Unit&) const {}
};
template <int ACT> struct EpiB16 {
    static constexpr bool PERM = true, AFTER_DRAIN = false;
    bf16_t* O; int ldc;
    DI void operator()(const f32x4 (&acc)[2][2][4][2], const pg8::Unit& u, int wr, int wc, int fr, int fq) const {
        const int row0 = u.pm * 256 + wr * 64 + fr, col0 = u.pn * 256 + wc * 32 + 8 * fq;
#pragma unroll
        for (int ai = 0; ai < 2; ++ai)
#pragma unroll
            for (int m = 0; m < 4; ++m) { bf16_t* rowp = O + (size_t)(row0 + ai * 128 + m * 16) * ldc + col0;
#pragma unroll
                for (int bj = 0; bj < 2; ++bj) { f32x4 v0 = acc[ai][bj][m][0], v1 = acc[ai][bj][m][1];
                    if (ACT == 1) {
#pragma unroll
                        for (int j = 0; j < 4; ++j) { const float a = fmaxf(v0[j], 0.f), b = fmaxf(v1[j], 0.f); v0[j] = a * a; v1[j] = b * b; } }
                    u32x4 w; w.x = pk2(v0[0], v0[1]); w.y = pk2(v0[2], v0[3]); w.z = pk2(v1[0], v1[1]); w.w = pk2(v1[2], v1[3]);
                    *(u32x4*)(rowp + bj * 128) = w; } }
    }
};
struct EpiResid {
    static constexpr bool PERM = false, AFTER_DRAIN = false;
    const float* xin; const float* ctxin; float* hlat; float* hctx; const float* modv; int gate_off; int layer0;
    DI void operator()(const f32x4 (&acc)[2][2][4][2], const pg8::Unit& u, int wr, int wc, int fr, int fq) const {
        const int b = u.pm / 9, j = u.pm - 9 * b;
        const float* src; float* dst; const float* gate;
        if (j == 0) { const size_t o = (size_t)b * NCTX * DM; dst = hctx + o; src = layer0 ? ctxin + o : dst; gate = modv + 16 * 6144 + gate_off; }
        else { const size_t o = ((size_t)b * LSEQ + (size_t)(j - 1) * 256) * DM; dst = hlat + o; src = layer0 ? xin + o : dst; gate = modv + b * 6144 + gate_off; }
        const int rloc = wr * 64 + fr, col0 = u.pn * 256 + wc * 32 + 4 * fq;
#pragma unroll
        for (int ai = 0; ai < 2; ++ai)
#pragma unroll
            for (int m = 0; m < 4; ++m) { const size_t ro = (size_t)(rloc + ai * 128 + m * 16) * DM + col0;
#pragma unroll
                for (int bj = 0; bj < 2; ++bj)
#pragma unroll
                    for (int n = 0; n < 2; ++n) { const size_t o = ro + bj * 128 + n * 16; const f32x4 hv = *(const f32x4*)(src + o); const f32x4 gv = *(const f32x4*)(gate + col0 + bj * 128 + n * 16);
                        *(f32x4*)(dst + o) = hv * ALPHA + gv * acc[ai][bj][m][n]; }
                asm volatile("" ::: "memory"); }
    }
};

struct CtxSplitOrder {
    int G, c;
    DI bool next(int i, pg8::Unit& u) const { const int L = i * G + c; if (L >= 256) return false; u.pm = (L >> 4) * 9; u.pn = (L >> 2) & 3; u.kq = L & 3; return true; }
    DI void a_ready(const pg8::Unit&) const {}
    DI void done(const pg8::Unit&) const {}
};
struct EpiPart {
    static constexpr bool PERM = false, AFTER_DRAIN = false;
    float* slab;
    DI void operator()(const f32x4 (&acc)[2][2][4][2], const pg8::Unit& u, int wr, int wc, int fr, int fq) const {
        float* base = slab + ((size_t)u.kq * 4096 + (size_t)(u.pm / 9) * 256 + wr * 64 + fr) * DM + u.pn * 256 + wc * 32 + 4 * fq;
#pragma unroll
        for (int ai = 0; ai < 2; ++ai)
#pragma unroll
            for (int m = 0; m < 4; ++m)
#pragma unroll
                for (int bj = 0; bj < 2; ++bj)
#pragma unroll
                    for (int n = 0; n < 2; ++n) *(f32x4*)(base + (size_t)(ai * 128 + m * 16) * DM + bj * 128 + n * 16) = acc[ai][bj][m][n];
    }
};
struct EpiResid2 {
    static constexpr bool PERM = true, AFTER_DRAIN = false;
    const float* xin; const float* ctxin; const bf16_t* zsrc; bf16_t* zdst; const float* stats; const float* lng; const float* lnb; const float* modv; int gate_off; int layer0;
    DI void operator()(const f32x4 (&acc)[2][2][4][2], const pg8::Unit& u, int wr, int wc, int fr, int fq) const {
        const int b = u.pm / 9, j = u.pm - 9 * b;
        const float* gate = modv + (j == 0 ? 16 : b) * 6144 + gate_off;
        const float* src32 = j == 0 ? ctxin + (size_t)b * NCTX * DM : xin + ((size_t)b * LSEQ + (size_t)(j - 1) * 256) * DM;
        const int rloc = wr * 64 + fr, col0 = u.pn * 256 + wc * 32 + 8 * fq;
#pragma unroll
        for (int ai = 0; ai < 2; ++ai)
#pragma unroll
            for (int m = 0; m < 4; ++m) { const int rl = rloc + ai * 128 + m * 16; const size_t rowu = (size_t)u.pm * 256 + rl;
                float mean = 0.f, rstd = 1.f; if (!layer0) { const f32x2 st2 = *(const f32x2*)(stats + 2 * rowu); mean = st2.x; rstd = st2.y; }
#pragma unroll
                for (int bj = 0; bj < 2; ++bj)
#pragma unroll
                    for (int n = 0; n < 2; ++n) { const int c = col0 + bj * 128 + 4 * n; f32x4 h;
                        if (layer0) h = *(const f32x4*)(src32 + (size_t)rl * DM + c);
                        else { const u32x2 zv = *(const u32x2*)(zsrc + rowu * DM + c); const f32x2 za = uph2(zv.x), zb = uph2(zv.y); const f32x4 z = {za.x, za.y, zb.x, zb.y};
                            h = (z - mean) * rstd * *(const f32x4*)(lng + c) + *(const f32x4*)(lnb + c); }
                        const f32x4 o = h * ALPHA + *(const f32x4*)(gate + c) * acc[ai][bj][m][n];
                        u32x2 w; w.x = pkh2(o.x, o.y); w.y = pkh2(o.z, o.w); *(u32x2*)(zdst + rowu * DM + c) = w; }
                asm volatile("" ::: "memory"); }
    }
};

struct TrItem { const float* W; bf16_t* WT; int K, N, k0, n0; };
DI void tr_load(const TrItem& t, float (&v)[8]) {
    const int tid = threadIdx.x;
#pragma unroll
    for (int p = 0; p < 8; ++p) { const int kk = p * 8 + (tid >> 6), n = tid & 63; v[p] = (t.n0 + n < t.N) ? t.W[(size_t)(t.k0 + kk) * t.N + t.n0 + n] : 0.f; }
}
DI void tr_store(const TrItem& t, const float (&v)[8], float* scr  ) {
    const int tid = threadIdx.x;
    __syncthreads();
#pragma unroll
    for (int p = 0; p < 8; ++p) { const int kk = p * 8 + (tid >> 6), n = tid & 63; scr[kk * 65 + n] = v[p]; }
    __syncthreads();
    { const int n = tid >> 3, kc = tid & 7; const float* s = scr + (kc * 8) * 65 + n;
      u32x4 o; o.x = pk2(s[0], s[65]); o.y = pk2(s[2 * 65], s[3 * 65]); o.z = pk2(s[4 * 65], s[5 * 65]); o.w = pk2(s[6 * 65], s[7 * 65]);
      *(u32x4*)(t.WT + (size_t)(t.n0 + n) * t.K + t.k0 + kc * 8) = o; }
}
constexpr int TR_AB = 16 * 52, TR_WO = 16 * 16, TR_W1 = 16 * 64, TR_W2 = 64 * 16, TR_CD = 16 * 40;
constexpr int TR_A = TR_AB + TR_WO, TR_B = TR_A + TR_W1 + TR_W2, TR_C = TR_B + TR_CD + TR_WO + TR_W1, TR_D = TR_C + TR_W2;
DI TrItem tr_decode(const Params& P, int it) {
    TrItem t; int r = it; int K = 1024, N = 1024; const float* W; bf16_t* WT;
    if (r < TR_AB) { W = P.in[I_ABW]; WT = (bf16_t*)(P.ws + WS_WAB); N = 3328; }
    else if ((r -= TR_AB) < TR_WO) { W = P.in[I_WOUT]; WT = (bf16_t*)(P.ws + WS_WOUT); }
    else if ((r -= TR_WO) < TR_W1) { W = P.in[I_W1]; WT = (bf16_t*)(P.ws + WS_W1); N = 4096; }
    else if ((r -= TR_W1) < TR_W2) { W = P.in[I_W2]; WT = (bf16_t*)(P.ws + WS_W2); K = 4096; }
    else if ((r -= TR_W2) < TR_CD) { W = P.in[I_CDW]; WT = (bf16_t*)(P.ws + WS_WCD); N = NCD; }
    else if ((r -= TR_CD) < TR_WO) { W = P.in[I_WOUT] + (size_t)1024 * 1024; WT = (bf16_t*)(P.ws + WS_WOUT) + (size_t)1024 * 1024; }
    else if ((r -= TR_WO) < TR_W1) { W = P.in[I_W1] + (size_t)1024 * 4096; WT = (bf16_t*)(P.ws + WS_W1) + (size_t)1024 * 4096; N = 4096; }
    else { r -= TR_W1; W = P.in[I_W2] + (size_t)1024 * 4096; WT = (bf16_t*)(P.ws + WS_W2) + (size_t)1024 * 4096; K = 4096; }
    const int nblk_k = K / 64; const int nb = r / nblk_k, kb = r - nb * nblk_k;
    t.W = W; t.WT = WT; t.K = K; t.N = N; t.k0 = kb * 64; t.n0 = nb * 64; return t;
}
DI void transpose_range(const Params& P, float* scr, int lo, int hi, int first_block, int nblocks) {
    if ((int)blockIdx.x < first_block || nblocks <= 0) return;
    int it = lo + ((int)blockIdx.x - first_block);
    if (it >= hi) return;
    TrItem cur = tr_decode(P, it); float v[8]; tr_load(cur, v);
    for (;;) { const int nx = it + nblocks; const bool more = nx < hi;
        TrItem nxt = cur; float w[8];
        if (more) { nxt = tr_decode(P, nx); tr_load(nxt, w); }
        tr_store(cur, v, scr);
        if (!more) break;
#pragma unroll
        for (int p = 0; p < 8; ++p) v[p] = w[p];
        cur = nxt; it = nx; }
    __syncthreads();
}
DI void phase_prep(const Params& P, unsigned char* lds) {
    const int tid = threadIdx.x; float* scr = (float*)lds;
    transpose_range(P, scr, 0, TR_D, 0, gridDim.x);
    float* sc = (float*)lds;
    float* red = sc + 17 * 1024;
    bool staged = false;
    for (int it = blockIdx.x; it < 192; it += gridDim.x) {
        __syncthreads();
        if (!staged) { for (int e = tid; e < 17 * 1024; e += 512) { const int r = e >> 10, k = e & 1023; const float v = r < 16 ? P.in[I_C][r * 1024 + k] : P.in[I_CCTX][k]; sc[e] = siluf_(v); } staged = true; __syncthreads(); }
        const int layer = it / 96, col0 = (it - layer * 96) * 64; const int cgp = tid & 63, ks = tid >> 6;
        const float* W = P.in[I_MODW] + (size_t)layer * 1024 * 6144 + col0 + cgp;
        float acc[17];
#pragma unroll
        for (int r = 0; r < 17; ++r) acc[r] = 0.f;
#pragma unroll 8
        for (int k = ks * 128; k < ks * 128 + 128; ++k) { const float w = W[(size_t)k * 6144];
#pragma unroll
            for (int r = 0; r < 17; ++r) acc[r] += sc[r * 1024 + k] * w; }
#pragma unroll
        for (int r = 0; r < 17; ++r) red[(ks * 17 + r) * 64 + cgp] = acc[r];
        __syncthreads();
        for (int e = tid; e < 17 * 64; e += 512) { const int r = e >> 6, cc = e & 63; float s = P.in[I_MODB][layer * 6144 + col0 + cc];
#pragma unroll
            for (int q = 0; q < 8; ++q) s += red[(q * 17 + r) * 64 + cc];
            ((float*)(P.ws + WS_MOD))[((size_t)layer * 17 + r) * 6144 + col0 + cc] = s; }
    }
}

template <int MODE>
DI void phase_rows(const Params& P, const bf16_t* zsrc, int layer_ln, int ln_g_idx, int ln_b_idx, int layer_mod, int mod_off, bool latonly) {
    const int lane = threadIdx.x & 63, gw = blockIdx.x * 8 + (threadIdx.x >> 6), ngw = gridDim.x * 8;
    float* stats = (float*)(P.ws + WS_HCTX);
    for (int r = gw; r < MROWS; r += ngw) {
        const int bb = r / TT, t = r - bb * TT; if (latonly && t < NCTX) continue;
        float v[2][8];
        if (MODE == 0) { const float* src = h0row_ptr(P, r);
#pragma unroll
            for (int j = 0; j < 2; ++j) { const f32x4 a = *(const f32x4*)(src + 8 * (lane + 64 * j)), c = *(const f32x4*)(src + 8 * (lane + 64 * j) + 4);
                v[j][0] = a.x; v[j][1] = a.y; v[j][2] = a.z; v[j][3] = a.w; v[j][4] = c.x; v[j][5] = c.y; v[j][6] = c.z; v[j][7] = c.w; } }
        else { const bf16_t* zp = zsrc + (size_t)r * DM; float s = 0.f;
#pragma unroll
            for (int j = 0; j < 2; ++j) { { const u32x4 q4 = *(const u32x4*)(zp + 8 * (lane + 64 * j)); const f32x2 a0 = uph2(q4.x), a1 = uph2(q4.y), a2 = uph2(q4.z), a3 = uph2(q4.w);
                v[j][0] = a0.x; v[j][1] = a0.y; v[j][2] = a1.x; v[j][3] = a1.y; v[j][4] = a2.x; v[j][5] = a2.y; v[j][6] = a3.x; v[j][7] = a3.y; }
#pragma unroll
                for (int i = 0; i < 8; ++i) s += v[j][i]; }
            const float mean = wave_sum_fast(s) * (1.f / 1024.f); float s2 = 0.f;
#pragma unroll
            for (int j = 0; j < 2; ++j)
#pragma unroll
                for (int i = 0; i < 8; ++i) { v[j][i] -= mean; s2 += v[j][i] * v[j][i]; }
            const float rstd = 1.0f / sqrtf(wave_sum_fast(s2) * (1.f / 1024.f) + 1e-5f);
            if (MODE == 1 && lane == 0) *(f32x2*)(stats + 2 * (size_t)r) = (f32x2){mean, rstd};
            const float* g = P.in[ln_g_idx] + layer_ln * 1024; const float* be = P.in[ln_b_idx] + layer_ln * 1024;
#pragma unroll
            for (int j = 0; j < 2; ++j) { const int c = 8 * (lane + 64 * j); const f32x4 g0 = *(const f32x4*)(g + c), g1 = *(const f32x4*)(g + c + 4), b0 = *(const f32x4*)(be + c), b1 = *(const f32x4*)(be + c + 4);
                v[j][0] = v[j][0] * rstd * g0.x + b0.x; v[j][1] = v[j][1] * rstd * g0.y + b0.y; v[j][2] = v[j][2] * rstd * g0.z + b0.z; v[j][3] = v[j][3] * rstd * g0.w + b0.w;
                v[j][4] = v[j][4] * rstd * g1.x + b1.x; v[j][5] = v[j][5] * rstd * g1.y + b1.y; v[j][6] = v[j][6] * rstd * g1.z + b1.z; v[j][7] = v[j][7] * rstd * g1.w + b1.w; } }
        if (MODE == 2) { float* op = P.out + ((size_t)bb * LSEQ + (t - NCTX)) * DM;
#pragma unroll
            for (int j = 0; j < 2; ++j) { const int c = 8 * (lane + 64 * j); *(f32x4*)(op + c) = (f32x4){v[j][0], v[j][1], v[j][2], v[j][3]}; *(f32x4*)(op + c + 4) = (f32x4){v[j][4], v[j][5], v[j][6], v[j][7]}; } }
        else { const float* mv = modrow_ptr(P, layer_mod, r) + mod_off; bf16_t* ap = (bf16_t*)(P.ws + WS_ABUF) + (size_t)r * DM;
#pragma unroll
            for (int j = 0; j < 2; ++j) { const int c = 8 * (lane + 64 * j); const f32x4 h0 = *(const f32x4*)(mv + c), h1 = *(const f32x4*)(mv + c + 4), c0 = *(const f32x4*)(mv + 1024 + c), c1 = *(const f32x4*)(mv + 1024 + c + 4);
                u32x4 w; w.x = pk2(v[j][0] * (c0.x + 1.0f) + h0.x, v[j][1] * (c0.y + 1.0f) + h0.y); w.y = pk2(v[j][2] * (c0.z + 1.0f) + h0.z, v[j][3] * (c0.w + 1.0f) + h0.w);
                w.z = pk2(v[j][4] * (c1.x + 1.0f) + h1.x, v[j][5] * (c1.y + 1.0f) + h1.y); w.w = pk2(v[j][6] * (c1.z + 1.0f) + h1.z, v[j][7] * (c1.w + 1.0f) + h1.w);
                *(u32x4*)(ap + c) = w; } }
    }
}

DI void phase_rows_ctx(const Params& P, const bf16_t* zsrc, const float* slab) {
    const int lane = threadIdx.x & 63, gw = blockIdx.x * 8 + (threadIdx.x >> 6), ngw = gridDim.x * 8;
    const float* stats = (const float*)(P.ws + WS_HCTX);
    const float* g1 = P.in[I_LNMG]; const float* b1 = P.in[I_LNMB]; const float* g2 = P.in[I_LNFG]; const float* b2 = P.in[I_LNFB];
    const float* gate = (const float*)(P.ws + WS_MOD) + 16 * 6144 + 5 * 1024;
    const float* mv = (const float*)(P.ws + WS_MOD) + ((size_t)17 + 16) * 6144;
    for (int rc = gw; rc < NB * NCTX; rc += ngw) {
        const int bb = rc >> 8, t = rc & 255; const size_t r = (size_t)bb * TT + t;
        const f32x2 st2 = *(const f32x2*)(stats + 2 * r);
        float v[2][8]; float s = 0.f;
#pragma unroll
        for (int j = 0; j < 2; ++j) { const int c = 8 * (lane + 64 * j);
            const u32x4 q4 = *(const u32x4*)(zsrc + r * DM + c); const f32x2 a0 = uph2(q4.x), a1 = uph2(q4.y), a2 = uph2(q4.z), a3 = uph2(q4.w);
            const float z[8] = {a0.x, a0.y, a1.x, a1.y, a2.x, a2.y, a3.x, a3.y};
            f32x4 f0 = {0.f, 0.f, 0.f, 0.f}, f1 = {0.f, 0.f, 0.f, 0.f};
#pragma unroll
            for (int kq = 0; kq < 4; ++kq) { const float* sp = slab + ((size_t)kq * 4096 + rc) * DM + c; f0 += *(const f32x4*)sp; f1 += *(const f32x4*)(sp + 4); }
            const float f[8] = {f0.x, f0.y, f0.z, f0.w, f1.x, f1.y, f1.z, f1.w};
            const f32x4 ga = *(const f32x4*)(g1 + c), gb = *(const f32x4*)(g1 + c + 4), ba = *(const f32x4*)(b1 + c), bbv = *(const f32x4*)(b1 + c + 4), ta = *(const f32x4*)(gate + c), tb = *(const f32x4*)(gate + c + 4);
            const float gg[8] = {ga.x, ga.y, ga.z, ga.w, gb.x, gb.y, gb.z, gb.w}, be[8] = {ba.x, ba.y, ba.z, ba.w, bbv.x, bbv.y, bbv.z, bbv.w}, gt[8] = {ta.x, ta.y, ta.z, ta.w, tb.x, tb.y, tb.z, tb.w};
#pragma unroll
            for (int i = 0; i < 8; ++i) { const float h = (z[i] - st2.x) * st2.y * gg[i] + be[i]; v[j][i] = ALPHA * h + gt[i] * f[i]; s += v[j][i]; } }
        const float mean = wave_sum_fast(s) * (1.f / 1024.f); float s2 = 0.f;
#pragma unroll
        for (int j = 0; j < 2; ++j)
#pragma unroll
            for (int i = 0; i < 8; ++i) { v[j][i] -= mean; s2 += v[j][i] * v[j][i]; }
        const float rstd = 1.0f / sqrtf(wave_sum_fast(s2) * (1.f / 1024.f) + 1e-5f);
        bf16_t* ap = (bf16_t*)(P.ws + WS_ABUF) + r * DM;
#pragma unroll
        for (int j = 0; j < 2; ++j) { const int c = 8 * (lane + 64 * j);
            const f32x4 ga = *(const f32x4*)(g2 + c), gb = *(const f32x4*)(g2 + c + 4), ba = *(const f32x4*)(b2 + c), bbv = *(const f32x4*)(b2 + c + 4);
            const f32x4 h0 = *(const f32x4*)(mv + c), h1 = *(const f32x4*)(mv + c + 4), c0 = *(const f32x4*)(mv + 1024 + c), c1 = *(const f32x4*)(mv + 1024 + c + 4);
            const float o0 = (v[j][0] * rstd * ga.x + ba.x) * (c0.x + 1.0f) + h0.x, o1 = (v[j][1] * rstd * ga.y + ba.y) * (c0.y + 1.0f) + h0.y, o2 = (v[j][2] * rstd * ga.z + ba.z) * (c0.z + 1.0f) + h0.z, o3 = (v[j][3] * rstd * ga.w + ba.w) * (c0.w + 1.0f) + h0.w;
            const float o4 = (v[j][4] * rstd * gb.x + bbv.x) * (c1.x + 1.0f) + h1.x, o5 = (v[j][5] * rstd * gb.y + bbv.y) * (c1.y + 1.0f) + h1.y, o6 = (v[j][6] * rstd * gb.z + bbv.z) * (c1.z + 1.0f) + h1.z, o7 = (v[j][7] * rstd * gb.w + bbv.w) * (c1.w + 1.0f) + h1.w;
            u32x4 w; w.x = pk2(o0, o1); w.y = pk2(o2, o3); w.z = pk2(o4, o5); w.w = pk2(o6, o7); *(u32x4*)(ap + c) = w; }
    }
}

DI void phase_rope(bf16_t* Pb, int ldp, int col0, int nvec) {
    const long total = (long)NB * LSEQ * nvec * 2; const long stride = (long)gridDim.x * 512;
    for (long e = (long)blockIdx.x * 512 + threadIdx.x; e < total; e += stride) {
        const int jq = (int)(e & 1); long q = e >> 1; const int vi = (int)(q % nvec); q /= nvec; const int i = (int)(q % LSEQ), b = (int)(q / LSEQ);
        bf16_t* p = Pb + (size_t)(b * TT + NCTX + i) * ldp + col0 + vi * 64 + jq * 8;
        float x0[8], x1[8], x2[8], x3[8];
        unpack8(*(const u32x4*)p, x0); unpack8(*(const u32x4*)(p + 16), x1); unpack8(*(const u32x4*)(p + 32), x2); unpack8(*(const u32x4*)(p + 48), x3);
        const float fr = (float)(i >> 6), fc = (float)(i & 63);
        float o0[8], o1[8], o2[8], o3[8];
#pragma unroll
        for (int j = 0; j < 8; ++j) { const float inv = exp2f(-(float)(jq * 8 + j) * (13.287712379549449f / 16.0f));
            const float ar = fr * inv, ac = fc * inv; const float cr = __cosf(ar), sr = __sinf(ar), cc = __cosf(ac), sc = __sinf(ac);
            o0[j] = x0[j] * cr - x1[j] * sr; o1[j] = x1[j] * cr + x0[j] * sr; o2[j] = x2[j] * cc - x3[j] * sc; o3[j] = x3[j] * cc + x2[j] * sc; }
        u32x4 w;
        w.x = pk2(o0[0], o0[1]); w.y = pk2(o0[2], o0[3]); w.z = pk2(o0[4], o0[5]); w.w = pk2(o0[6], o0[7]); *(u32x4*)p = w;
        w.x = pk2(o1[0], o1[1]); w.y = pk2(o1[2], o1[3]); w.z = pk2(o1[4], o1[5]); w.w = pk2(o1[6], o1[7]); *(u32x4*)(p + 16) = w;
        w.x = pk2(o2[0], o2[1]); w.y = pk2(o2[2], o2[3]); w.z = pk2(o2[4], o2[5]); w.w = pk2(o2[6], o2[7]); *(u32x4*)(p + 32) = w;
        w.x = pk2(o3[0], o3[1]); w.y = pk2(o3[2], o3[3]); w.z = pk2(o3[4], o3[5]); w.w = pk2(o3[6], o3[7]); *(u32x4*)(p + 48) = w;
    }
}
template <int DV>
DI void phase_vt(const bf16_t* Pb, int ldp, int vcol0, int nh, bf16_t* Vt, unsigned char* lds) {
    bf16_t* tile = (bf16_t*)lds; constexpr int RS = DV + 2;
    constexpr int NCH = 64 * (DV / 8) / 512;
    const int tid = threadIdx.x; const int nitems = NB * nh * (TT / 64);
    u32x4 pv[NCH];
#define VT_LOAD(it_) do { const int kb_ = (it_) % (TT / 64); const int q_ = (it_) / (TT / 64); const int hh_ = q_ % nh, b_ = q_ / nh; \
        _Pragma("unroll") for (int j_ = 0; j_ < NCH; ++j_) { const int e_ = tid + 512 * j_; const int key_ = e_ / (DV / 8), c8_ = (e_ % (DV / 8)) * 8; \
            pv[j_] = *(const u32x4*)(Pb + (size_t)(b_ * TT + kb_ * 64 + key_) * ldp + vcol0 + hh_ * DV + c8_); } } while (0)
    if ((int)blockIdx.x < nitems) VT_LOAD(blockIdx.x);
    for (int it = blockIdx.x; it < nitems; it += gridDim.x) {
        const int kb = it % (TT / 64); const int q = it / (TT / 64); const int hh = q % nh, b = q / nh;
        __syncthreads();
#pragma unroll
        for (int j = 0; j < NCH; ++j) { const int e = tid + 512 * j; const int key = e / (DV / 8), c8 = (e % (DV / 8)) * 8;
            unsigned* d = (unsigned*)(tile + key * RS + c8); d[0] = pv[j].x; d[1] = pv[j].y; d[2] = pv[j].z; d[3] = pv[j].w; }
        __syncthreads();
        if (it + (int)gridDim.x < nitems) VT_LOAD(it + gridDim.x);
        for (int e = tid; e < DV * 8; e += 512) { const int d = e >> 3, kc = e & 7; const bf16_t* t = tile + (kc * 8) * RS + d;
            u32x4 o; o.x = (unsigned)t[0] | ((unsigned)t[RS] << 16); o.y = (unsigned)t[2 * RS] | ((unsigned)t[3 * RS] << 16); o.z = (unsigned)t[4 * RS] | ((unsigned)t[5 * RS] << 16); o.w = (unsigned)t[6 * RS] | ((unsigned)t[7 * RS] << 16);
            *(u32x4*)(Vt + ((size_t)(b * nh + hh) * DV + d) * TT + kb * 64 + kc * 8) = o; }
    }
#undef VT_LOAD
    __syncthreads();
}
DI void phase_conv(const Params& P) {
    const bf16_t* Pb = (const bf16_t*)(P.ws + WS_BIG + BIG_P); bf16_t* X = (bf16_t*)(P.ws + WS_BIG + BIG_XBC);
    const long total = (long)MROWS * 128; const long stride = (long)gridDim.x * 512;
    for (long e = (long)blockIdx.x * 512 + threadIdx.x; e < total; e += stride) {
        const int c8 = (int)(e & 127) * 8; const int r = (int)(e >> 7); const int t = r % TT; const int lo = t < NCTX ? 0 : NCTX, hi = t < NCTX ? NCTX : TT;
        float acc[8];
        { const f32x4 b0 = *(const f32x4*)(P.in[I_CONVB] + c8), b1 = *(const f32x4*)(P.in[I_CONVB] + c8 + 4);
          acc[0] = b0.x; acc[1] = b0.y; acc[2] = b0.z; acc[3] = b0.w; acc[4] = b1.x; acc[5] = b1.y; acc[6] = b1.z; acc[7] = b1.w; }
        u32x4 xk[5];
#pragma unroll
        for (int k = 0; k < 5; ++k) { const int tq = t + k - 2; const bool ok = tq >= lo && tq < hi;
            xk[k] = *(const u32x4*)(Pb + (size_t)(r + (ok ? k - 2 : 0)) * LDP1 + 512 + c8); if (!ok) xk[k] = (u32x4){0u, 0u, 0u, 0u}; }
#pragma unroll
        for (int k = 0; k < 5; ++k) { const u32x4 xv = xk[k];
            const f32x4 w0 = *(const f32x4*)(P.in[I_CONVW] + k * 1024 + c8), w1 = *(const f32x4*)(P.in[I_CONVW] + k * 1024 + c8 + 4);
            acc[0] += lo2f(xv.x) * w0.x; acc[1] += hi2f(xv.x) * w0.y; acc[2] += lo2f(xv.y) * w0.z; acc[3] += hi2f(xv.y) * w0.w;
            acc[4] += lo2f(xv.z) * w1.x; acc[5] += hi2f(xv.z) * w1.y; acc[6] += lo2f(xv.w) * w1.z; acc[7] += hi2f(xv.w) * w1.w; }
        u32x4 o; o.x = pk2(siluf_(acc[0]), siluf_(acc[1])); o.y = pk2(siluf_(acc[2]), siluf_(acc[3])); o.z = pk2(siluf_(acc[4]), siluf_(acc[5])); o.w = pk2(siluf_(acc[6]), siluf_(acc[7]));
        *(u32x4*)(X + (size_t)r * 1024 + c8) = o;
    }
}

template <int NMAP, int NDB, bool WIN>
DI void attn_tiles(f32x16 (&o)[NMAP][NDB], float (&mref)[NMAP], float (&lsum)[NMAP], const bf16x8 (&qf)[NMAP][4],
                   const bf16_t* Kb  , int ldk, const bf16_t* Vt  ,
                   int nkt, int r32, int hi, int qpos, int kpos0) {
    for (int kt = 0; kt < nkt; ++kt) {
        const bf16_t* kp = Kb + (size_t)(kt * 32 + r32) * ldk + hi * 8;
        const bf16_t* vp = Vt + (size_t)r32 * TT + kt * 32 + 4 * hi;
        bf16x8 pf[NMAP][2];
#pragma unroll
        for (int m = 0; m < NMAP; ++m) {
            bf16x8 kf[4];
#pragma unroll
            for (int s = 0; s < 4; ++s) kf[s] = *(const bf16x8*)(kp + m * 64 + s * 16);
            f32x16 st;
#pragma unroll
            for (int i = 0; i < 16; ++i) st[i] = 0.f;
#pragma unroll
            for (int s = 0; s < 4; ++s) st = MFMA32(kf[s], qf[m][s], st);
            if (WIN) {
#pragma unroll
                for (int i = 0; i < 16; ++i) { const int dlt = qpos - (kpos0 + kt * 32 + crow(i, hi)); if (dlt > 128 || dlt < -128) st[i] = -INFINITY; } }
            float mx = st[0];
#pragma unroll
            for (int i = 1; i < 16; ++i) mx = fmaxf(mx, st[i]);
            mx = fmaxf(mx, __shfl_xor(mx, 32));
            if (__any((mx - mref[m]) * C2 > 8.0f)) { const float nm = fmaxf(mref[m], mx); const float f = exp2f((mref[m] - nm) * C2); lsum[m] *= f; mref[m] = nm;
#pragma unroll
                for (int db = 0; db < NDB; ++db)
#pragma unroll
                    for (int i = 0; i < 16; ++i) o[m][db][i] *= f; }
            const float nmc = -mref[m] * C2; float ls = 0.f;
#pragma unroll
            for (int i = 0; i < 16; ++i) { st[i] = __builtin_amdgcn_exp2f(st[i] * C2 + nmc); ls += st[i]; }
            lsum[m] += ls;
#pragma unroll
            for (int s = 0; s < 2; ++s) { u32x4 w; w.x = pk2(st[8 * s], st[8 * s + 1]); w.y = pk2(st[8 * s + 2], st[8 * s + 3]); w.z = pk2(st[8 * s + 4], st[8 * s + 5]); w.w = pk2(st[8 * s + 6], st[8 * s + 7]);
                pf[m][s] = __builtin_bit_cast(bf16x8, w); }
        }
#pragma unroll
        for (int db = 0; db < NDB; ++db) {
            bf16x8 vf[2];
#pragma unroll
            for (int s = 0; s < 2; ++s) { const s16x4 a = *(const s16x4*)(vp + (size_t)db * 32 * TT + 16 * s), b = *(const s16x4*)(vp + (size_t)db * 32 * TT + 16 * s + 8);
                vf[s] = __builtin_shufflevector(a, b, 0, 1, 2, 3, 4, 5, 6, 7); }
#pragma unroll
            for (int m = 0; m < NMAP; ++m)
#pragma unroll
                for (int s = 0; s < 2; ++s) o[m][db] = MFMA32(vf[s], pf[m][s], o[m][db]);
        }
    }
}
DI void diff_attn_block(const Params& P, unsigned char* lds, int b, int h, int qrow0, int nt, float lam) {
    const int tid = threadIdx.x, lane = tid & 63, wave = tid >> 6, r32 = lane & 31, hi = lane >> 5, m = wave >> 2, qt = wave & 3;
    const bf16_t* Pb = (const bf16_t*)(P.ws + WS_BIG + BIG_P);
    constexpr int KRS = 136, VRS = 68, STG = 64 * KRS + 128 * VRS;
    bf16_t* stg = (bf16_t*)lds;
    const int qrow = qrow0 + qt * 32 + r32;
    bf16_t* qs = stg + 3 * STG + (size_t)(wave * 4) * 64 * 8;
    bf16x8 qf[4];
    { const bf16_t* qp = Pb + (size_t)qrow * LDP0 + 1792 + h * 128 + m * 64 + hi * 8;
#pragma unroll
      for (int s = 0; s < 4; ++s) { float qv[8]; unpack8(*(const u32x4*)(qp + s * 16), qv);
          u32x4 w; w.x = pk2(qv[0] * C2, qv[1] * C2); w.y = pk2(qv[2] * C2, qv[3] * C2); w.z = pk2(qv[4] * C2, qv[5] * C2); w.w = pk2(qv[6] * C2, qv[7] * C2); qf[s] = __builtin_bit_cast(bf16x8, w); } }
    f32x16 o[4]; float mref = 0.f, lsum = 0.f;
#pragma unroll
    for (int db = 0; db < 4; ++db)
#pragma unroll
        for (int i = 0; i < 16; ++i) o[db][i] = 0.f;
    const bf16_t* Kg = Pb + (size_t)(b * TT) * LDP0 + 1792 + 512 + h * 128;
    const bf16_t* Vg = (const bf16_t*)(P.ws + WS_BIG + BIG_VT0) + (size_t)((b * 4 + h) * 128) * TT;
    const int kkey0 = tid >> 4, kc = (tid & 15) * 8;
    const int vd0 = tid >> 3, vc = (tid & 7) * 8;
    u32x4 kr0, kr1, vr0, vr1;
#define DA_LOAD(t) do { const bf16_t* kp_ = Kg + (size_t)((t) * 64 + kkey0) * LDP0 + kc; kr0 = *(const u32x4*)kp_; kr1 = *(const u32x4*)(kp_ + (size_t)32 * LDP0); \
        const bf16_t* vp_ = Vg + (size_t)vd0 * TT + (t) * 64 + vc; vr0 = *(const u32x4*)vp_; vr1 = *(const u32x4*)(vp_ + (size_t)64 * TT); } while (0)
#define DA_STORE(sb) do { bf16_t* ks_ = stg + (sb) * STG; *(u32x4*)(ks_ + kkey0 * KRS + kc) = kr0; *(u32x4*)(ks_ + (kkey0 + 32) * KRS + kc) = kr1; \
        bf16_t* vs_ = ks_ + 64 * KRS; *(u32x2*)(vs_ + vd0 * VRS + vc) = (u32x2){vr0.x, vr0.y}; *(u32x2*)(vs_ + vd0 * VRS + vc + 4) = (u32x2){vr0.z, vr0.w}; \
        *(u32x2*)(vs_ + (vd0 + 64) * VRS + vc) = (u32x2){vr1.x, vr1.y}; *(u32x2*)(vs_ + (vd0 + 64) * VRS + vc + 4) = (u32x2){vr1.z, vr1.w}; } while (0)
    __syncthreads();
#pragma unroll
    for (int s = 0; s < 4; ++s) *(bf16x8*)(qs + (s * 64 + lane) * 8) = qf[s];
    DA_LOAD(0); DA_STORE(0); DA_LOAD(1); DA_STORE(1);
    __syncthreads();
#define DA_QK(dst, sb, ci) do { const bf16_t* ks_ = stg + (sb) * STG; const float ci_ = (ci); \
        _Pragma("unroll") for (int kb = 0; kb < 2; ++kb) { _Pragma("unroll") for (int i = 0; i < 16; ++i) dst[kb][i] = ci_; \
            _Pragma("unroll") for (int s = 0; s < 4; ++s) { const bf16x8 kf = *(const bf16x8*)(ks_ + (kb * 32 + r32) * KRS + m * 64 + s * 16 + hi * 8); const bf16x8 qq = *(const bf16x8*)(qs + (s * 64 + lane) * 8); dst[kb] = MFMA32(kf, qq, dst[kb]); } } } while (0)
    f32x16 st[2], sn[2];
    DA_QK(st, 0, 0.f);
    int s0 = 0, s1 = 1, s2 = 2;
    for (int t = 0; t < nt; ++t) {
        if (t + 2 < nt) DA_LOAD(t + 2);
        if (t + 1 < nt) DA_QK(sn, s1, -mref);
        const bf16_t* vs = stg + s0 * STG + 64 * KRS;
        float mx = fmaxf(st[0][0], st[1][0]);
#pragma unroll
        for (int i = 1; i < 16; ++i) mx = fmaxf(mx, fmaxf(st[0][i], st[1][i]));
        mx = fmaxf(mx, __shfl_xor(mx, 32));
        if (t == 0 || __any(mx > 8.0f)) {
            const float dl = t == 0 ? mx : fmaxf(mx, 0.f); const float f = __builtin_amdgcn_exp2f(-dl); mref += dl;
#pragma unroll
            for (int i = 0; i < 16; ++i) { st[0][i] -= dl; st[1][i] -= dl; sn[0][i] -= dl; sn[1][i] -= dl; }
            lsum *= f;
#pragma unroll
            for (int db = 0; db < 4; ++db)
#pragma unroll
                for (int i = 0; i < 16; ++i) o[db][i] *= f; }
        bf16x8 pf[4]; float ls = 0.f;
#pragma unroll
        for (int kb = 0; kb < 2; ++kb) {
#pragma unroll
            for (int i = 0; i < 16; ++i) { st[kb][i] = __builtin_amdgcn_exp2f(st[kb][i]); ls += st[kb][i]; }
#pragma unroll
            for (int s = 0; s < 2; ++s) { u32x4 w; w.x = pk2(st[kb][8 * s], st[kb][8 * s + 1]); w.y = pk2(st[kb][8 * s + 2], st[kb][8 * s + 3]); w.z = pk2(st[kb][8 * s + 4], st[kb][8 * s + 5]); w.w = pk2(st[kb][8 * s + 6], st[kb][8 * s + 7]);
                pf[kb * 2 + s] = __builtin_bit_cast(bf16x8, w); } }
        lsum += ls;
#pragma unroll
        for (int db = 0; db < 4; ++db)
#pragma unroll
            for (int k4 = 0; k4 < 4; ++k4) { const bf16_t* vp = vs + (db * 32 + r32) * VRS + k4 * 16 + 4 * hi;
                const s16x4 a = *(const s16x4*)vp, bq = *(const s16x4*)(vp + 8);
                o[db] = MFMA32(__builtin_shufflevector(a, bq, 0, 1, 2, 3, 4, 5, 6, 7), pf[k4], o[db]); }
        if (t + 2 < nt) DA_STORE(s2);
        __syncthreads();
        st[0] = sn[0]; st[1] = sn[1];
        { const int tmp = s0; s0 = s1; s1 = s2; s2 = tmp; }
    }
#undef DA_QK
#undef DA_LOAD
#undef DA_STORE
    float* xbuf = (float*)lds;
    const float lt = lsum + __shfl_xor(lsum, 32);
    const float sc = (m ? lam : 1.0f) / lt;
    if (m) {
#pragma unroll
        for (int db = 0; db < 4; ++db)
#pragma unroll
            for (int i = 0; i < 16; ++i) xbuf[(db * 32 + crow(i, hi)) * 128 + qt * 32 + r32] = o[db][i] * sc; }
    __syncthreads();
    if (!m) { float ss = 0.f;
#pragma unroll
        for (int db = 0; db < 4; ++db)
#pragma unroll
            for (int i = 0; i < 16; ++i) { const float v = o[db][i] * sc - xbuf[(db * 32 + crow(i, hi)) * 128 + qt * 32 + r32]; o[db][i] = v; ss += v * v; }
        ss += __shfl_xor(ss, 32);
        const float rs = (1.0f / sqrtf(ss * (1.f / 128.f) + 1e-5f)) * 0.8f;
        bf16_t* op = (bf16_t*)(P.ws + WS_ABUF) + (size_t)qrow * DM + 512 + h * 128; const float* sg = P.in[I_SUBLN];
#pragma unroll
        for (int db = 0; db < 4; ++db)
#pragma unroll
            for (int g = 0; g < 4; ++g) { const int d = db * 32 + 8 * g + 4 * hi; const f32x4 gg = *(const f32x4*)(sg + d);
                u32x2 w; w.x = pk2(o[db][4 * g] * rs * gg.x, o[db][4 * g + 1] * rs * gg.y); w.y = pk2(o[db][4 * g + 2] * rs * gg.z, o[db][4 * g + 3] * rs * gg.w);
                *(u32x2*)(op + d) = w; } }
}
DI void phase_diff_attn(const Params& P, unsigned char* lds) {
    const int lane = threadIdx.x & 63;
    float lam;
    { const float a = P.in[I_LQ1][lane] * P.in[I_LK1][lane], b2 = P.in[I_LQ2][lane] * P.in[I_LK2][lane]; lam = expf(wave_sum(a)) - expf(wave_sum(b2)) + 0.2f; }
    for (int it = blockIdx.x; it < 1152; it += gridDim.x) {
        if (it < 1024) { const int xcd = it & 7, j = it >> 3; const int qb = j & 15, bh = (j >> 4) * 8 + xcd; const int h = bh & 3, b = bh >> 2;
            diff_attn_block(P, lds, b, h, b * TT + NCTX + qb * 128, 36, lam); }
        else { const int e = it - 1024; const int qb = e & 1, h = (e >> 1) & 3, b = e >> 3; diff_attn_block(P, lds, b, h, b * TT + qb * 128, 4, lam); }
    }
    __syncthreads();
}
DI void swa_block(const Params& P, unsigned char* lds, int b, int kvh, int i0) {
    const int tid = threadIdx.x, lane = tid & 63, wave = tid >> 6, r32 = lane & 31, hi = lane >> 5, g = wave & 3, qt = wave >> 2, hq = kvh * 4 + g;
    const bf16_t* Pb = (const bf16_t*)(P.ws + WS_BIG + BIG_P);
    constexpr int KRS = 72, VRS = 68, STG = 64 * KRS + 64 * VRS;
    bf16_t* stg = (bf16_t*)lds;
    const int qpos = i0 + qt * 32 + r32; const int qrow = b * TT + NCTX + qpos;
    bf16x8 qf[4];
    { const bf16_t* qp = Pb + (size_t)qrow * LDP1 + 1552 + hq * 64 + hi * 8;
#pragma unroll
      for (int s = 0; s < 4; ++s) qf[s] = *(const bf16x8*)(qp + s * 16); }
    f32x16 o[2]; float mref = -INFINITY, lsum = 0.f;
#pragma unroll
    for (int db = 0; db < 2; ++db)
#pragma unroll
        for (int i = 0; i < 16; ++i) o[db][i] = 0.f;
    const bf16_t* Kg = Pb + (size_t)(b * TT) * LDP1 + 1552 + 512 + kvh * 64;
    const bf16_t* Vg = (const bf16_t*)(P.ws + WS_BIG + BIG_VT1) + (size_t)((b * 2 + kvh) * 64) * TT;
    const int wlo = i0 - 128 < 0 ? 0 : i0 - 128; const int whi = i0 + 192 > LSEQ ? LSEQ : i0 + 192; const int nt = 4 + (whi - wlo) / 64;
    const int kkey = tid >> 3, kc = (tid & 7) * 8;
    u32x4 kr, vr;
#define SW_KEY0(t) ((t) < 4 ? 64 * (t) : NCTX + wlo + 64 * ((t) - 4))
#define SW_LOAD(t) do { const int k0_ = SW_KEY0(t); kr = *(const u32x4*)(Kg + (size_t)(k0_ + kkey) * LDP1 + kc); vr = *(const u32x4*)(Vg + (size_t)kkey * TT + k0_ + kc); } while (0)
#define SW_STORE(sb) do { bf16_t* ks_ = stg + (sb) * STG; *(u32x4*)(ks_ + kkey * KRS + kc) = kr; bf16_t* vs_ = ks_ + 64 * KRS; \
        *(u32x2*)(vs_ + kkey * VRS + kc) = (u32x2){vr.x, vr.y}; *(u32x2*)(vs_ + kkey * VRS + kc + 4) = (u32x2){vr.z, vr.w}; } while (0)
    __syncthreads();
    SW_LOAD(0); SW_STORE(0);
    __syncthreads();
    for (int t = 0; t < nt; ++t) {
        if (t + 1 < nt) SW_LOAD(t + 1);
        const bf16_t* ks = stg + (t & 1) * STG; const bf16_t* vs = ks + 64 * KRS;
        f32x16 st[2];
#pragma unroll
        for (int kb = 0; kb < 2; ++kb) {
#pragma unroll
            for (int i = 0; i < 16; ++i) st[kb][i] = 0.f;
#pragma unroll
            for (int s = 0; s < 4; ++s) { const bf16x8 kf = *(const bf16x8*)(ks + (kb * 32 + r32) * KRS + s * 16 + hi * 8); st[kb] = MFMA32(kf, qf[s], st[kb]); } }
        if (t >= 4) { const int kp0 = wlo + 64 * (t - 4);
#pragma unroll
            for (int kb = 0; kb < 2; ++kb)
#pragma unroll
                for (int i = 0; i < 16; ++i) { const int dlt = qpos - (kp0 + kb * 32 + crow(i, hi)); if (dlt > 128 || dlt < -128) st[kb][i] = -INFINITY; } }
        float mx = fmaxf(st[0][0], st[1][0]);
#pragma unroll
        for (int i = 1; i < 16; ++i) mx = fmaxf(mx, fmaxf(st[0][i], st[1][i]));
        mx = fmaxf(mx, __shfl_xor(mx, 32));
        if (__any((mx - mref) * C2 > 8.0f)) { const float nm = fmaxf(mref, mx); const float f = exp2f((mref - nm) * C2); lsum *= f; mref = nm;
#pragma unroll
            for (int db = 0; db < 2; ++db)
#pragma unroll
                for (int i = 0; i < 16; ++i) o[db][i] *= f; }
        const float nmc = -mref * C2; float ls = 0.f;
        bf16x8 pf[4];
#pragma unroll
        for (int kb = 0; kb < 2; ++kb) {
#pragma unroll
            for (int i = 0; i < 16; ++i) { st[kb][i] = __builtin_amdgcn_exp2f(st[kb][i] * C2 + nmc); ls += st[kb][i]; }
#pragma unroll
            for (int s = 0; s < 2; ++s) { u32x4 w; w.x = pk2(st[kb][8 * s], st[kb][8 * s + 1]); w.y = pk2(st[kb][8 * s + 2], st[kb][8 * s + 3]); w.z = pk2(st[kb][8 * s + 4], st[kb][8 * s + 5]); w.w = pk2(st[kb][8 * s + 6], st[kb][8 * s + 7]);
                pf[kb * 2 + s] = __builtin_bit_cast(bf16x8, w); } }
        lsum += ls;
#pragma unroll
        for (int db = 0; db < 2; ++db)
#pragma unroll
            for (int k4 = 0; k4 < 4; ++k4) { const bf16_t* vp = vs + (db * 32 + r32) * VRS + k4 * 16 + 4 * hi;
                const s16x4 a = *(const s16x4*)vp, bq = *(const s16x4*)(vp + 8);
                o[db] = MFMA32(__builtin_shufflevector(a, bq, 0, 1, 2, 3, 4, 5, 6, 7), pf[k4], o[db]); }
        if (t + 1 < nt) SW_STORE((t + 1) & 1);
        __syncthreads();
    }
#undef SW_KEY0
#undef SW_LOAD
#undef SW_STORE
    float l = lsum + __shfl_xor(lsum, 32);
    l += exp2f(P.in[I_SINK][hq] * LOG2E - mref * C2);
    const float il = 1.0f / l;
    bf16_t* op = (bf16_t*)(P.ws + WS_ABUF) + (size_t)qrow * DM + 512 + hq * 64;
#pragma unroll
    for (int db = 0; db < 2; ++db)
#pragma unroll
        for (int gq = 0; gq < 4; ++gq) { const int dd = db * 32 + 8 * gq + 4 * hi;
            u32x2 w; w.x = pk2(o[db][4 * gq] * il, o[db][4 * gq + 1] * il); w.y = pk2(o[db][4 * gq + 2] * il, o[db][4 * gq + 3] * il);
            *(u32x2*)(op + dd) = w; }
}
DI void phase_swa(const Params& P, unsigned char* lds) {
    for (int it = blockIdx.x; it < 1024; it += gridDim.x) { const int qb = it & 31, kvh = (it >> 5) & 1, b = it >> 6; swa_block(P, lds, b, kvh, qb * 64); }
    __syncthreads();
}

struct RwOps { f32x4 w0, w1, m0, m1, k0, k1, b0, b1, r0, r1; float vv; };
template <int d>
DI void rwkv_chain_t(const Params& P, unsigned char* lds, int chain) {
    const int tid = threadIdx.x, lane = tid & 63, wave = tid >> 6;
    const int b = chain >> 4, h = (chain >> 1) & 7;
    const bf16_t* Pb = (const bf16_t*)(P.ws + WS_BIG + BIG_P);
    constexpr int CT = 64, TWS = 72;
    float* rs = (float*)lds;
    float* ks = rs + 4096; float* vs = ks + 4096;
    float* wd = vs + 4096; float* km = wd + 4096; float* kk = km + 4096; float* bv = kk + 4096;
    bf16_t* raw = (bf16_t*)wd;
    bf16_t* yb = (bf16_t*)(bv + 4096);
    bf16_t* tw = yb + 4096;
    bf16_t* xa = tw + CT * TWS;
    float* rsq = (float*)(xa + CT * TWS);
    bf16_t* yout = (bf16_t*)(P.ws + WS_BIG + BIG_Y0) + (size_t)d * MROWS * 512;
    const int mat = wave >> 2, jl = (wave & 3) * 16 + (lane & 15), quad = lane >> 4;
    bf16x8 bw[2];
    { const float* W = (mat ? P.in[I_RA2] : P.in[I_RW2]) + (size_t)(d * 64) * 512 + h * 64 + jl;
#pragma unroll
      for (int s2 = 0; s2 < 2; ++s2) { const float* wp_ = W + (size_t)(32 * s2 + 8 * quad) * 512;
          u32x4 w; w.x = pk2(wp_[0], wp_[512]); w.y = pk2(wp_[2 * 512], wp_[3 * 512]); w.z = pk2(wp_[4 * 512], wp_[5 * 512]); w.w = pk2(wp_[6 * 512], wp_[7 * 512]);
          bw[s2] = __builtin_bit_cast(bf16x8, w); } }
    const float c0v = (mat ? P.in[I_RA0] : P.in[I_RW0])[d * 512 + h * 64 + jl], kkvj = P.in[I_RKK][h * 64 + jl], kavj = P.in[I_RKA][h * 64 + jl];
    __syncthreads();
    float* mus = rsq + CT;
    float* kks = mus + 320;
    if (tid < 320) { const int g = tid >> 6, cc = tid & 63; mus[tid] = P.in[I_MU][(g < 3 ? g * 512 + h * 64 : (g == 3 ? 1536 : 1600)) + cc]; }
    if (tid < 64) kks[tid] = P.in[I_RKK][h * 64 + tid];
    const int stt = tid >> 3, sc8 = (tid & 7) * 8;
    f32x2 S0a = {0.f, 0.f}, S0b = {0.f, 0.f}, S1a = {0.f, 0.f}, S1b = {0.f, 0.f};
    const int v0 = wave * 8 + 2 * (lane >> 4), kc = (lane & 15) * 4; const bool evn = (lane & 1) == 0;
    u32x4 rg[6];
#define RW_TLO(c) (d == 0 ? 64 * (c) : ((c) < 4 ? 192 - 64 * (c) : 2496 - 64 * (c)))
#define RW_LOAD(c) do { const int tlo_ = RW_TLO(c); const int slo_ = tlo_ < NCTX ? 0 : NCTX, shi_ = tlo_ < NCTX ? NCTX : TT; \
        _Pragma("unroll") for (int q_ = 0; q_ < 6; ++q_) { const int e_ = tid + 512 * q_; rg[q_] = (u32x4){0u, 0u, 0u, 0u}; \
            if (e_ < 66 * 40) { const int rr_ = e_ / 40, rem_ = e_ - rr_ * 40, g_ = rem_ >> 3, c8_ = rem_ & 7; const int tq_ = tlo_ - 1 + rr_; \
                const int col_ = g_ < 3 ? g_ * 512 + h * 64 : (g_ == 3 ? 1536 : 1600); \
                if (tq_ >= slo_ && tq_ < shi_) rg[q_] = *(const u32x4*)(Pb + (size_t)(b * TT + tq_) * LDP0 + col_ + c8_ * 8); } } } while (0)
    RW_LOAD(0);
    for (int c = 0; c < 36; ++c) {
        const int tlo = RW_TLO(c);
#pragma unroll
        for (int q = 0; q < 6; ++q) { const int e = tid + 512 * q; if (e < 66 * 40) { const int rr = e / 40, rem = e - rr * 40; *(u32x4*)(raw + rr * 320 + rem * 8) = rg[q]; } }
        __syncthreads();
        if (c > 0) { const int tt = tid >> 3, c8 = tid & 7; *(u32x4*)(yout + (size_t)(b * TT + RW_TLO(c - 1) + tt) * 512 + h * 64 + c8 * 8) = *(const u32x4*)(yb + tt * 64 + c8 * 8); }
#pragma unroll
        for (int g = 0; g < 5; ++g) {
            float cu[8], pv[8], nx[8], sv[8];
            unpack8(*(const u32x4*)(raw + (stt + 1) * 320 + g * 64 + sc8), cu); unpack8(*(const u32x4*)(raw + stt * 320 + g * 64 + sc8), pv); unpack8(*(const u32x4*)(raw + (stt + 2) * 320 + g * 64 + sc8), nx);
            const f32x4 m0 = *(const f32x4*)(mus + g * 64 + sc8), m1 = *(const f32x4*)(mus + g * 64 + sc8 + 4);
            const float mm[8] = {m0.x, m0.y, m0.z, m0.w, m1.x, m1.y, m1.z, m1.w};
#pragma unroll
            for (int j = 0; j < 8; ++j) sv[j] = cu[j] + mm[j] * (0.5f * (pv[j] + nx[j]) - cu[j]);
            if (g < 3) { float* dst = g == 0 ? rs : (g == 1 ? ks : vs);
                *(f32x4*)(dst + stt * 64 + sc8) = (f32x4){sv[0], sv[1], sv[2], sv[3]}; *(f32x4*)(dst + stt * 64 + sc8 + 4) = (f32x4){sv[4], sv[5], sv[6], sv[7]};
                if (g == 1) { const f32x4 k0 = *(const f32x4*)(kks + sc8), k1 = *(const f32x4*)(kks + sc8 + 4); const float kq[8] = {k0.x, k0.y, k0.z, k0.w, k1.x, k1.y, k1.z, k1.w};
                    float ssq = 0.f;
#pragma unroll
                    for (int j = 0; j < 8; ++j) { const float q_ = sv[j] * kq[j]; ssq += q_ * q_; }
                    ssq = reduce8(ssq);
                    if ((tid & 7) == 0) rsq[stt] = 1.0f / sqrtf(fmaxf(ssq, 1e-24f)); } }
            else { if (g == 3) {
#pragma unroll
                    for (int j = 0; j < 8; ++j) sv[j] = tanhf_(sv[j]); }
                u32x4 w; w.x = pk2(sv[0], sv[1]); w.y = pk2(sv[2], sv[3]); w.z = pk2(sv[4], sv[5]); w.w = pk2(sv[6], sv[7]);
                *(u32x4*)((g == 3 ? tw : xa) + stt * TWS + sc8) = w; } }
        __syncthreads();
        if (c + 1 < 36) RW_LOAD(c + 1);
        { const bf16_t* src = mat ? xa : tw;
#pragma unroll 1
          for (int th = 0; th < 4; ++th) { f32x4 acc = {c0v, c0v, c0v, c0v};
              const bf16x8 af0 = *(const bf16x8*)(src + (th * 16 + (lane & 15)) * TWS + 8 * quad), af1 = *(const bf16x8*)(src + (th * 16 + (lane & 15)) * TWS + 32 + 8 * quad);
              acc = __builtin_amdgcn_mfma_f32_16x16x32_bf16(af0, bw[0], acc, 0, 0, 0); acc = __builtin_amdgcn_mfma_f32_16x16x32_bf16(af1, bw[1], acc, 0, 0, 0);
#pragma unroll
              for (int rg_ = 0; rg_ < 4; ++rg_) { const int tt = th * 16 + quad * 4 + rg_, o_ = tt * 64 + jl;
                  if (mat == 0) { wd[o_] = __expf(-0.6065306597126334f * sigmoidf_(acc[rg_])); }
                  else { const float a_ = sigmoidf_(acc[rg_]); const float kraw = ks[o_]; const float kkn = kraw * kkvj * rsq[tt];
                      km[o_] = kraw * (1.0f + (a_ - 1.0f) * kavj); kk[o_] = kkn; bv[o_] = kkn * a_; } } } }
        __syncthreads();
        { struct { f32x4 w, m, k, b, r; f32x2 vv; } cur, nxt;
#define RW_LD(dst, tt_) do { const int o_ = (tt_) * 64 + kc; dst.w = *(const f32x4*)(wd + o_); dst.m = *(const f32x4*)(km + o_); dst.k = *(const f32x4*)(kk + o_); dst.b = *(const f32x4*)(bv + o_); \
            dst.r = *(const f32x4*)(rs + o_); dst.vv = *(const f32x2*)(vs + (tt_) * 64 + v0); } while (0)
          RW_LD(cur, d ? CT - 1 : 0);
#pragma unroll 1
          for (int q = 0; q < CT / 8; ++q) { float yk = 0.f;
#pragma unroll
              for (int j = 0; j < 8; ++j) { const int n = q * 8 + j; const int nn = n + 1 < CT ? n + 1 : CT - 1;
                  RW_LD(nxt, d ? CT - 1 - nn : nn);
                  f32x2 a0 = S0a * cur.k.xy + S0b * cur.k.zw, a1 = S1a * cur.k.xy + S1b * cur.k.zw;
                  const float sa0 = -reduce16(a0.x + a0.y), sa1 = -reduce16(a1.x + a1.y);
                  S0a = S0a * cur.w.xy + sa0 * cur.b.xy + cur.vv.x * cur.m.xy; S0b = S0b * cur.w.zw + sa0 * cur.b.zw + cur.vv.x * cur.m.zw;
                  S1a = S1a * cur.w.xy + sa1 * cur.b.xy + cur.vv.y * cur.m.xy; S1b = S1b * cur.w.zw + sa1 * cur.b.zw + cur.vv.y * cur.m.zw;
                  f32x2 y0 = S0a * cur.r.xy + S0b * cur.r.zw, y1 = S1a * cur.r.xy + S1b * cur.r.zw;
                  const float p0 = y0.x + y0.y, p1 = y1.x + y1.y;
                  const float e0 = p0 + dpp_x1(p0), e1 = p1 + dpp_x1(p1);
                  float yq = evn ? e0 : e1;
                  yq += dpp_x2(yq); yq += dpp_ror4(yq); yq += dpp_ror8(yq);
                  yk = (((lane & 15) >> 1) == j) ? yq : yk;
                  cur.w = nxt.w; cur.m = nxt.m; cur.k = nxt.k; cur.b = nxt.b; cur.r = nxt.r; cur.vv = nxt.vv; }
              { const int n = q * 8 + ((lane & 15) >> 1); const int tt = d ? CT - 1 - n : n; yb[tt * 64 + v0 + (lane & 1)] = f2bf(yk); } }
#undef RW_LD
        }
        __syncthreads();
    }
    { const int tt = tid >> 3, c8 = tid & 7; *(u32x4*)(yout + (size_t)(b * TT + RW_TLO(35) + tt) * 512 + h * 64 + c8 * 8) = *(const u32x4*)(yb + tt * 64 + c8 * 8); }
#undef RW_LOAD
#undef RW_TLO
    __syncthreads();
}
DI void rwkv_chain(const Params& P, unsigned char* lds, int chain) { if (chain & 1) rwkv_chain_t<1>(P, lds, chain); else rwkv_chain_t<0>(P, lds, chain); }
DI void phase_rwkv_finish(const Params& P, unsigned char* lds) {
    const int tid = threadIdx.x, lane = tid & 63, h = tid >> 6, r32 = lane & 31, hi = lane >> 5;
    const bf16_t* Pb = (const bf16_t*)(P.ws + WS_BIG + BIG_P);
    const bf16_t* y0 = (const bf16_t*)(P.ws + WS_BIG + BIG_Y0); const bf16_t* y1 = y0 + (size_t)MROWS * 512;
    bf16_t* sgb = (bf16_t*)lds;
    float* G = (float*)(lds + 8704);
    bf16x8 bfr[2][8];
#pragma unroll
    for (int nb = 0; nb < 2; ++nb)
#pragma unroll
        for (int s = 0; s < 8; ++s) { const float* gp = P.in[I_RG2] + (size_t)(16 * s + 8 * hi) * 512 + h * 64 + nb * 32 + r32;
            u32x4 w; w.x = pk2(gp[0], gp[512]); w.y = pk2(gp[2 * 512], gp[3 * 512]); w.z = pk2(gp[4 * 512], gp[5 * 512]); w.w = pk2(gp[6 * 512], gp[7 * 512]);
            bfr[nb][s] = __builtin_bit_cast(bf16x8, w); }
    const float mur = P.in[I_MU][tid], muk = P.in[I_MU][512 + tid], muv = P.in[I_MU][1024 + tid];
    const float rk = P.in[I_RRK][tid], gng = P.in[I_GNG][tid], gnb = P.in[I_GNB][tid];
    const int stt = tid >> 4, sc8 = (tid & 15) * 8;
    float mug[8];
#pragma unroll
    for (int j = 0; j < 8; ++j) mug[j] = P.in[I_MU][1664 + sc8 + j];
    for (int it = blockIdx.x; it < MROWS / 32; it += gridDim.x) {
        const int r0 = it * 32; const int t0 = r0 % TT; const int slo = t0 < NCTX ? 0 : NCTX, shi = t0 < NCTX ? NCTX : TT;
        __syncthreads();
        { const int t = t0 + stt; const bf16_t* p = Pb + (size_t)(r0 + stt) * LDP0 + 1664 + sc8;
          float c[8], pv[8], nx[8]; const u32x4 z = {0u, 0u, 0u, 0u};
          const bool hp_ = t - 1 >= slo, hn_ = t + 1 < shi; const u32x4 qc = *(const u32x4*)p, qp = *(const u32x4*)(hp_ ? p - LDP0 : p), qn = *(const u32x4*)(hn_ ? p + LDP0 : p);
          unpack8(qc, c); unpack8(hp_ ? qp : z, pv); unpack8(hn_ ? qn : z, nx);
          float sg[8];
#pragma unroll
          for (int j = 0; j < 8; ++j) sg[j] = sigmoidf_(c[j] + mug[j] * (0.5f * (pv[j] + nx[j]) - c[j]));
          u32x4 w; w.x = pk2(sg[0], sg[1]); w.y = pk2(sg[2], sg[3]); w.z = pk2(sg[4], sg[5]); w.w = pk2(sg[6], sg[7]);
          *(u32x4*)(sgb + stt * 136 + sc8) = w; }
        __syncthreads();
        { f32x16 acc[2]; bf16x8 afr[8];
#pragma unroll
          for (int i = 0; i < 16; ++i) { acc[0][i] = 0.f; acc[1][i] = 0.f; }
#pragma unroll
          for (int s = 0; s < 8; ++s) afr[s] = *(const bf16x8*)(sgb + r32 * 136 + 16 * s + 8 * hi);
#pragma unroll
          for (int s = 0; s < 8; ++s) { acc[0] = MFMA32(afr[s], bfr[0][s], acc[0]); acc[1] = MFMA32(afr[s], bfr[1][s], acc[1]); }
#pragma unroll
          for (int nb = 0; nb < 2; ++nb)
#pragma unroll
              for (int i = 0; i < 16; ++i) G[crow(i, hi) * 512 + h * 64 + nb * 32 + r32] = acc[nb][i]; }
        __syncthreads();
        { const bf16_t* p = Pb + (size_t)r0 * LDP0 + tid;
          float rp = 0.f, kp = 0.f, vp = 0.f;
          if (t0 - 1 >= slo) { rp = bf2f(*(p - LDP0)); kp = bf2f(*(p - LDP0 + 512)); vp = bf2f(*(p - LDP0 + 1024)); }
          float rc = bf2f(p[0]), kc_ = bf2f(p[512]), vc = bf2f(p[1024]);
#pragma unroll 4
          for (int tt = 0; tt < 32; ++tt) { const int r = r0 + tt; const bf16_t* pn = p + (size_t)(tt + 1) * LDP0;
              const bool hn = t0 + tt + 1 < shi; const bf16_t* pq = hn ? pn : p;
              float rn = bf2f(pq[0]), kn = bf2f(pq[512]), vn = bf2f(pq[1024]); if (!hn) { rn = 0.f; kn = 0.f; vn = 0.f; }
              const float r_s = rc + mur * (0.5f * (rp + rn) - rc), k_s = kc_ + muk * (0.5f * (kp + kn) - kc_), v_s = vc + muv * (0.5f * (vp + vn) - vc);
              const float bonus = wave_sum_fast(r_s * k_s * rk) * v_s;
              const float y = bf2f(y0[(size_t)r * 512 + tid]) + bf2f(y1[(size_t)r * 512 + tid]);
              const float mean = wave_sum_fast(y) * (1.f / 64.f); const float dy = y - mean; const float var = wave_sum_fast(dy * dy) * (1.f / 64.f);
              const float yn = dy * (1.0f / sqrtf(var + 64e-5f)) * gng + gnb;
              ((bf16_t*)(P.ws + WS_ABUF))[(size_t)r * DM + tid] = f2bf((yn + bonus) * G[tt * 512 + tid]);
              rp = rc; kp = kc_; vp = vc; rc = rn; kc_ = kn; vc = vn; } }
    }
    __syncthreads();
}

DI void ssd_chain(const Params& P, unsigned char* lds, int chain) {
    const int tid = threadIdx.x, lane = tid & 63, wave = tid >> 6, r32 = lane & 31, hi = lane >> 5;
    const int b = chain >> 4, h = (chain >> 1) & 7, d = chain & 1, g = h >> 2;
    const bf16_t* Pb = (const bf16_t*)(P.ws + WS_BIG + BIG_P); const bf16_t* X = (const bf16_t*)(P.ws + WS_BIG + BIG_XBC);
    bf16_t* yout = (bf16_t*)(P.ws + WS_BIG + BIG_Y1) + (size_t)d * MROWS * 512;
    constexpr int RS = 136, TS = 72;
    bf16_t* Cb = (bf16_t*)lds;
    bf16_t* Bb = Cb + 64 * RS;
    bf16_t* Hb = Bb + 64 * RS;
    bf16_t* BdT = Hb + 64 * RS;
    bf16_t* XT = BdT + 128 * TS;
    bf16_t* Yb = XT + 64 * TS;
    float* dec0 = (float*)(Yb + 64 * TS);
    const float dtb = P.in[I_DTB][d * 8 + h], aneg = -expf(P.in[I_ALOG][d * 8 + h]);
    __syncthreads();
    for (int e = tid; e < 64 * RS / 2; e += 512) ((unsigned*)Hb)[e] = 0u;
    f32x16 hacc;
#pragma unroll
    for (int i = 0; i < 16; ++i) hacc[i] = 0.f;
    const int hpb = wave >> 2, hnb = wave & 3;
#define SSD_TLO(c) (d == 0 ? 64 * (c) : ((c) < 4 ? 192 - 64 * (c) : 2496 - 64 * (c)))
    u32x4 pc0, pc1, pb0, pb1, xreg; float praw = 0.f;
#define SSD_LOAD(c) do { const size_t row0_ = (size_t)b * TT + SSD_TLO(c); \
        { const int s_ = tid >> 4, c8 = (tid & 15) * 8; const size_t r0_ = row0_ + (d ? 63 - s_ : s_), r1_ = row0_ + (d ? 31 - s_ : s_ + 32); \
          pc0 = *(const u32x4*)(X + r0_ * 1024 + 768 + g * 128 + c8); pb0 = *(const u32x4*)(X + r0_ * 1024 + 512 + g * 128 + c8); \
          pc1 = *(const u32x4*)(X + r1_ * 1024 + 768 + g * 128 + c8); pb1 = *(const u32x4*)(X + r1_ * 1024 + 512 + g * 128 + c8); } \
        { const int s_ = tid >> 3, c8 = (tid & 7) * 8; const size_t r_ = row0_ + (d ? 63 - s_ : s_); xreg = *(const u32x4*)(X + r_ * 1024 + h * 64 + c8); } \
        if (wave == 4) { const size_t r_ = row0_ + (d ? 63 - lane : lane); praw = bf2f(Pb[r_ * LDP1 + 1536 + d * 8 + h]); } } while (0)
#define SSD_SCAN(k) do { float* a_ = dec0 + (k) * 320; const float dt_ = softplusf_(praw + dtb); float cs_ = dt_ * aneg; \
        _Pragma("unroll") for (int off_ = 1; off_ < 64; off_ <<= 1) { const float u_ = __shfl_up(cs_, off_); if (lane >= off_) cs_ += u_; } \
        const float tot_ = __shfl(cs_, 63); a_[lane] = cs_; a_[64 + lane] = __expf(tot_ - cs_); a_[128 + lane] = __expf(cs_); a_[192 + lane] = dt_; if (lane == 0) a_[256] = __expf(tot_); } while (0)
    SSD_LOAD(0);
    if (wave == 4) SSD_SCAN(0);
    for (int c = 0; c < 36; ++c) {
        const int tlo = SSD_TLO(c);
        const size_t row0 = (size_t)b * TT + tlo;
        const float* acs = dec0 + (c & 1) * 320; const float* dte = acs + 64; const float* eacs = dte + 64; const float* dts = eacs + 64; const float* etot = dts + 64;
        const u32x4 xcur = xreg;
        { const int s_ = tid >> 4, c8 = (tid & 15) * 8;
          *(u32x4*)(Cb + s_ * RS + c8) = pc0; *(u32x4*)(Bb + s_ * RS + c8) = pb0; *(u32x4*)(Cb + (s_ + 32) * RS + c8) = pc1; *(u32x4*)(Bb + (s_ + 32) * RS + c8) = pb1;
        }
        __syncthreads();
        if (c + 1 < 36) SSD_LOAD(c + 1);
        { const int s_ = tid >> 3, c8 = (tid & 7) * 8; float xv[8]; unpack8(xcur, xv); const float dt = dts[s_];
#pragma unroll
          for (int j = 0; j < 8; ++j) XT[(c8 + j) * TS + s_] = f2bf(xv[j] * dt);
          const int n0 = (tid & 7) * 16; const float de = dte[s_]; float bvv[8];
#pragma unroll
          for (int q = 0; q < 2; ++q) { unpack8(*(const u32x4*)(Bb + s_ * RS + n0 + q * 8), bvv);
#pragma unroll
              for (int j = 0; j < 8; ++j) BdT[(n0 + q * 8 + j) * TS + s_] = f2bf(bvv[j] * de); } }
        __syncthreads();
        if (wave < 4 && tlo >= NCTX) { const int lb = wave >> 1, pb = wave & 1; const int l = lb * 32 + r32; const float acl = acs[l];
            bf16x8 cf[8], af[8];
#pragma unroll
            for (int ks = 0; ks < 8; ++ks) { cf[ks] = *(const bf16x8*)(Cb + l * RS + 16 * ks + 8 * hi); af[ks] = *(const bf16x8*)(Hb + (pb * 32 + r32) * RS + 16 * ks + 8 * hi); }
            f32x16 yt;
#pragma unroll
            for (int i = 0; i < 16; ++i) yt[i] = 0.f;
#pragma unroll
            for (int ks = 0; ks < 8; ++ks) yt = MFMA32(af[ks], cf[ks], yt);
            { const float el = eacs[l];
#pragma unroll
              for (int i = 0; i < 16; ++i) yt[i] *= el; }
            for (int sb = 0; sb <= lb; ++sb) { f32x16 gt;
#pragma unroll
                for (int ks = 0; ks < 8; ++ks) af[ks] = *(const bf16x8*)(Bb + (sb * 32 + r32) * RS + 16 * ks + 8 * hi);
                s16x4 xa_[2], xb_[2];
#pragma unroll
                for (int k2 = 0; k2 < 2; ++k2) { const bf16_t* xp = XT + (pb * 32 + r32) * TS + sb * 32 + 16 * k2 + 4 * hi; xa_[k2] = *(const s16x4*)xp; xb_[k2] = *(const s16x4*)(xp + 8); }
                f32x4 as4[4];
#pragma unroll
                for (int g4 = 0; g4 < 4; ++g4) as4[g4] = *(const f32x4*)(acs + sb * 32 + 8 * g4 + 4 * hi);
#pragma unroll
                for (int i = 0; i < 16; ++i) gt[i] = 0.f;
#pragma unroll
                for (int ks = 0; ks < 8; ++ks) gt = MFMA32(af[ks], cf[ks], gt);
#pragma unroll
                for (int i = 0; i < 16; ++i) { const int s_ = sb * 32 + crow(i, hi); gt[i] = (l >= s_) ? gt[i] * __expf(acl - as4[i >> 2][i & 3]) : 0.f; }
#pragma unroll
                for (int k2 = 0; k2 < 2; ++k2) { u32x4 w; w.x = pk2(gt[8 * k2], gt[8 * k2 + 1]); w.y = pk2(gt[8 * k2 + 2], gt[8 * k2 + 3]); w.z = pk2(gt[8 * k2 + 4], gt[8 * k2 + 5]); w.w = pk2(gt[8 * k2 + 6], gt[8 * k2 + 7]);
                    yt = MFMA32(__builtin_shufflevector(xa_[k2], xb_[k2], 0, 1, 2, 3, 4, 5, 6, 7), __builtin_bit_cast(bf16x8, w), yt); } }
#pragma unroll
            for (int i = 0; i < 16; ++i) Yb[l * TS + pb * 32 + crow(i, hi)] = f2bf(yt[i]); }
        if (wave == 4 && c + 1 < 36) SSD_SCAN((c + 1) & 1);
        { const float et = etot[0]; bf16x8 ha[4], hb[4];
#pragma unroll
          for (int i = 0; i < 16; ++i) hacc[i] *= et;
#pragma unroll
          for (int ks = 0; ks < 4; ++ks) { ha[ks] = *(const bf16x8*)(XT + (hpb * 32 + r32) * TS + 16 * ks + 8 * hi); hb[ks] = *(const bf16x8*)(BdT + (hnb * 32 + r32) * TS + 16 * ks + 8 * hi); }
#pragma unroll
          for (int ks = 0; ks < 4; ++ks) hacc = MFMA32(ha[ks], hb[ks], hacc); }
        __syncthreads();
#pragma unroll
        for (int i = 0; i < 16; ++i) Hb[(hpb * 32 + crow(i, hi)) * RS + hnb * 32 + r32] = f2bf(hacc[i]);
        if (tlo >= NCTX) { const int l = tid >> 3, c8 = (tid & 7) * 8; const size_t r = row0 + (d ? 63 - l : l); *(u32x4*)(yout + r * 512 + h * 64 + c8) = *(const u32x4*)(Yb + l * TS + c8); }
        __syncthreads();
    }
}
DI void phase_ssd_finish(const Params& P) {
    const int lane = threadIdx.x & 63, gw = blockIdx.x * 8 + (threadIdx.x >> 6), ngw = gridDim.x * 8;
    const bf16_t* Pb = (const bf16_t*)(P.ws + WS_BIG + BIG_P); const bf16_t* X = (const bf16_t*)(P.ws + WS_BIG + BIG_XBC);
    const bf16_t* y0 = (const bf16_t*)(P.ws + WS_BIG + BIG_Y1); const bf16_t* y1 = y0 + (size_t)MROWS * 512;
    const int c8 = lane * 8; const float dsk = P.in[I_SSDD][lane >> 3];
    const f32x4 g0 = *(const f32x4*)(P.in[I_NORMG] + c8), g1 = *(const f32x4*)(P.in[I_NORMG] + c8 + 4);
    constexpr int NR = NB * LSEQ;
#define SF_ROW(i_) ((size_t)((i_) / LSEQ) * TT + NCTX + (i_) % LSEQ)
    u32x4 nz, nx, na, nb;
    if (gw < NR) { const size_t r = SF_ROW(gw); nz = *(const u32x4*)(Pb + r * LDP1 + c8); nx = *(const u32x4*)(X + r * 1024 + c8); na = *(const u32x4*)(y0 + r * 512 + c8); nb = *(const u32x4*)(y1 + r * 512 + c8); }
    for (int i = gw; i < NR; i += ngw) { const size_t r = SF_ROW(i);
        const u32x4 zv = nz, xv = nx, av = na, bv = nb;
        if (i + ngw < NR) { const size_t rn = SF_ROW(i + ngw); nz = *(const u32x4*)(Pb + rn * LDP1 + c8); nx = *(const u32x4*)(X + rn * 1024 + c8); na = *(const u32x4*)(y0 + rn * 512 + c8); nb = *(const u32x4*)(y1 + rn * 512 + c8); }
        float z[8], x[8], ya[8], yb_[8]; unpack8(zv, z); unpack8(xv, x); unpack8(av, ya); unpack8(bv, yb_);
        float v[8]; float ss = 0.f;
#pragma unroll
        for (int j = 0; j < 8; ++j) { v[j] = (ya[j] + yb_[j] + dsk * x[j]) * siluf_(z[j]); ss += v[j] * v[j]; }
        ss += dpp_x1(ss); ss += dpp_x2(ss); ss += dpp_hm(ss); ss += dpp_rm(ss);
        { auto q2 = __builtin_amdgcn_permlane16_swap(__float_as_uint(ss), __float_as_uint(ss), false, false); ss = __uint_as_float(q2[0]) + __uint_as_float(q2[1]); }
        const float rs = 1.0f / sqrtf(ss * (1.f / 256.f) + 1e-5f);
        u32x4 o; o.x = pk2(v[0] * rs * g0.x, v[1] * rs * g0.y); o.y = pk2(v[2] * rs * g0.z, v[3] * rs * g0.w); o.z = pk2(v[4] * rs * g1.x, v[5] * rs * g1.y); o.w = pk2(v[6] * rs * g1.z, v[7] * rs * g1.w);
        *(u32x4*)((bf16_t*)(P.ws + WS_ABUF) + r * DM + c8) = o; }
#undef SF_ROW
}


#define XB_TMO      128
#define XB_XCNT(j)  (256  + 64 * (j))
#define XB_XSUB(j)  (1280 + 64 * (j))
#define XB_XGEN(j)  (2304 + 64 * (j))
#define XB_TOP      3328
#define XB_TOPGEN   3392
#define XCD_BAR_WORDS 3456
#define XB_SPIN_CAP (1u << 18)

__device__ __forceinline__ unsigned xb_ld(unsigned* p)              { return __hip_atomic_load(p, __ATOMIC_RELAXED, __HIP_MEMORY_SCOPE_AGENT); }
__device__ __forceinline__ unsigned xb_add(unsigned* p, unsigned v) { return __hip_atomic_fetch_add(p, v, __ATOMIC_RELAXED, __HIP_MEMORY_SCOPE_AGENT); }
__device__ __forceinline__ unsigned xb_xcc_id() { return (unsigned)__builtin_amdgcn_s_getreg((3 << 11) | 20) & 0xFu; }
#define XB_SPIN(cond, bar) do { unsigned _sp = 0; while (cond) { __builtin_amdgcn_s_sleep(1); \
    if ((++_sp & 255u) == 0u) { if (xb_ld(&(bar)[XB_TMO])) break; if (_sp > XB_SPIN_CAP) { atomicAdd(&(bar)[XB_TMO], 1u); break; } } } } while (0)

struct XcdBarrier {
    unsigned* bar; unsigned x;
    volatile LAS unsigned* st;
};

__device__ __forceinline__ XcdBarrier xcd_barrier_post(unsigned* bar, volatile LAS unsigned* st) {
    XcdBarrier b; b.bar = bar; b.x = xb_xcc_id(); b.st = st;
    if (threadIdx.x == 0) (void)xb_add(&bar[XB_XCNT(b.x)], 1u);
    return b;
}
__device__ __forceinline__ void xcd_barrier_complete(unsigned* bar, unsigned x, unsigned& nloc, unsigned& nx) {
    const unsigned G = gridDim.x * gridDim.y * gridDim.z;
    unsigned sum, cnt, mine, sp = 0u;
    for (;;) {
        sum = 0u; cnt = 0u; mine = 0u;
#pragma unroll
        for (unsigned j = 0; j < 16; ++j) { const unsigned c = xb_ld(&bar[XB_XCNT(j)]); sum += c; cnt += (c > 0u) ? 1u : 0u; mine = (j == x) ? c : mine; }
        if (sum == G) break;
        __builtin_amdgcn_s_sleep(1);
        if ((++sp & 255u) == 0u) { if (xb_ld(&bar[XB_TMO])) break; if (sp > XB_SPIN_CAP) { atomicAdd(&bar[XB_TMO], 1u); break; } }
    }
    nloc = mine > 0u ? mine : 1u; nx = cnt > 0u ? cnt : 1u;
}

__device__ __forceinline__ void xcd_barrier(const XcdBarrier& b) {
    asm volatile("s_waitcnt vmcnt(0)" ::: "memory");
    __syncthreads();
    if (threadIdx.x == 0) {
        unsigned* bar = b.bar;
        __builtin_amdgcn_s_waitcnt(0);
        unsigned nloc = b.st[0], nx = b.st[1];
        if (nloc == 0u) { xcd_barrier_complete(bar, b.x, nloc, nx); b.st[0] = nloc; b.st[1] = nx; }
        const unsigned old = xb_add(&bar[XB_XSUB(b.x)], 1u);
        const unsigned gen = old / nloc;
        if (old + 1u == (gen + 1u) * nloc) {
            __builtin_amdgcn_fence(__ATOMIC_RELEASE, "agent");
            asm volatile("s_waitcnt vmcnt(0)" ::: "memory");
            const unsigned og = xb_add(&bar[XB_TOP], 1u);
            const unsigned tg = og / nx;
            if (og + 1u == (tg + 1u) * nx) xb_add(&bar[XB_TOPGEN], 1u);
            else XB_SPIN(xb_ld(&bar[XB_TOPGEN]) == tg, bar);
            __builtin_amdgcn_fence(__ATOMIC_ACQUIRE, "agent");
            xb_add(&bar[XB_XGEN(b.x)], 1u);
            asm volatile("s_waitcnt vmcnt(0)" ::: "memory");
        } else {
            XB_SPIN(xb_ld(&bar[XB_XGEN(b.x)]) == gen, bar);
            __builtin_amdgcn_fence(__ATOMIC_ACQUIRE, "agent");
            asm volatile("s_waitcnt vmcnt(0)" ::: "memory");
        }
    }
    __syncthreads();
}

template <class Epi>
DI void run_gemm(unsigned char* lds, const bf16_t* A, const bf16_t* Bt, int N, int K, bool latonly, const Epi& E) {
    MyOrder S; S.init(latonly ? 128 : 144, N / 256, gridDim.x, blockIdx.x, latonly ? 1 : 0);
    pg8::Gemm g; g.A = A; g.Bt = Bt; g.M = MROWS; g.N = N; g.K = K; g.ld = K;
    pg8::gemm_phase<Epi, MyOrder, false>((PG8_LAS unsigned char*)lds, g, S, E, nullptr);
}
DI EpiResid2 make_resid2(const Params& P, int layer, int gate_off, int layer0, const bf16_t* zsrc, bf16_t* zdst, int g_idx, int b_idx, int layer_ln) {
    EpiResid2 e; e.xin = P.in[I_X]; e.ctxin = P.in[I_CTX]; e.zsrc = zsrc; e.zdst = zdst; e.stats = (const float*)(P.ws + WS_HCTX);
    e.lng = P.in[g_idx] + layer_ln * 1024; e.lnb = P.in[b_idx] + layer_ln * 1024; e.modv = (const float*)(P.ws + WS_MOD) + (size_t)layer * 17 * 6144; e.gate_off = gate_off; e.layer0 = layer0; return e;
}

__global__ void __launch_bounds__(512) mega(Params P) {
    extern __shared__ __attribute__((aligned(16))) unsigned char lds[];
    cg::grid_group grid = cg::this_grid();
    volatile LAS unsigned* xst = (volatile LAS unsigned*)(lds + 147456);
    if (threadIdx.x == 0) { xst[0] = 0u; xst[1] = 0u; }
    __syncthreads();
    XcdBarrier xb = xcd_barrier_post((unsigned*)(P.ws + WS_BAR), xst);
    bf16_t* ABUF = (bf16_t*)(P.ws + WS_ABUF); bf16_t* PB = (bf16_t*)(P.ws + WS_BIG + BIG_P); bf16_t* ZB0 = (bf16_t*)P.out; bf16_t* ZB1 = (bf16_t*)(P.ws + WS_BIG + BIG_Z1);
#define PHASE(k) if (P.ph_lo <= (k) && (k) < P.ph_hi)
#define PSYNC(k) do { if ((k) > P.ph_lo) { if (P.ph_lo < 0) grid.sync();   xcd_barrier(xb); } } while (0)
#if !defined(ONLY) || ONLY == 0
    PHASE(0) { PSYNC(0); REP(0) phase_prep(P, lds); }
#endif
#if !defined(ONLY) || ONLY == 1
    if ((REP_MASK >> 26) & 1u) { for (int q_ = 0; q_ < 16; ++q_) xcd_barrier(xb); }
    PHASE(1) { PSYNC(1); REP(1) phase_rows<0>(P, nullptr, 0, 0, 0, 0, 0, false); }
#endif
#if !defined(ONLY) || ONLY == 2
    PHASE(2) { PSYNC(2); REP(2) { EpiB16<0> e; e.O = PB; e.ldc = LDP0; run_gemm(lds, ABUF, (const bf16_t*)(P.ws + WS_WAB), 3328, 1024, false, e); } }
#endif
#if !defined(ONLY) || ONLY == 3
    PHASE(3) { PSYNC(3); REP(19) for (int ch = blockIdx.x; ch < 256; ch += gridDim.x) rwkv_chain(P, lds, ch);
                phase_rope(PB, LDP0, 1792, 16); REP(24) phase_vt<128>(PB, LDP0, 1792 + 1024, 4, (bf16_t*)(P.ws + WS_BIG + BIG_VT0), lds); }
#endif
#if !defined(ONLY) || ONLY == 4
    PHASE(4) { PSYNC(4); REP(20) phase_diff_attn(P, lds); REP(21) phase_rwkv_finish(P, lds); }
#endif
#if !defined(ONLY) || ONLY == 5
    PHASE(5) { PSYNC(5); REP(5) { EpiResid2 e = make_resid2(P, 0, 2 * 1024, 1, ZB0, ZB0, I_LNMG, I_LNMB, 0); run_gemm(lds, ABUF, (const bf16_t*)(P.ws + WS_WOUT), 1024, 1024, false, e); } }
#endif
#if !defined(ONLY) || ONLY == 6
    PHASE(6) { PSYNC(6); phase_rows<1>(P, ZB0, 0, I_LNMG, I_LNMB, 0, 3 * 1024, false); }
#endif
#if !defined(ONLY) || ONLY == 7
    PHASE(7) { PSYNC(7); REP(7) { EpiB16<1> e; e.O = PB; e.ldc = 4096; run_gemm(lds, ABUF, (const bf16_t*)(P.ws + WS_W1), 4096, 1024, false, e); } }
#endif
#if !defined(ONLY) || ONLY == 8
    PHASE(8) { PSYNC(8); { EpiResid2 e = make_resid2(P, 0, 5 * 1024, 0, ZB0, ZB0, I_LNMG, I_LNMB, 0); run_gemm(lds, PB, (const bf16_t*)(P.ws + WS_W2), 1024, 4096, true, e); }
                 { EpiPart e2; e2.slab = (float*)ZB1; CtxSplitOrder S2; S2.G = gridDim.x; S2.c = blockIdx.x; pg8::Gemm g2; g2.A = PB; g2.Bt = (const bf16_t*)(P.ws + WS_W2); g2.M = MROWS; g2.N = 1024; g2.K = 1024; g2.ld = 4096;
                   pg8::gemm_phase<EpiPart, CtxSplitOrder, false>((PG8_LAS unsigned char*)lds, g2, S2, e2, nullptr); } }
#endif
#if !defined(ONLY) || ONLY == 9
    PHASE(9) { PSYNC(9); phase_rows<1>(P, ZB0, 0, I_LNFG, I_LNFB, 1, 0, true); phase_rows_ctx(P, ZB0, (const float*)ZB1); }
#endif
#if !defined(ONLY) || ONLY == 10
    PHASE(10) { PSYNC(10); REP(10) { EpiB16<0> e; e.O = PB; e.ldc = LDP1; run_gemm(lds, ABUF, (const bf16_t*)(P.ws + WS_WCD), 2560, 1024, false, e); } }
#endif
#if !defined(ONLY) || ONLY == 11
    PHASE(11) { PSYNC(11); REP(11) phase_conv(P); phase_rope(PB, LDP1, 1552, 10); REP(25) phase_vt<64>(PB, LDP1, 1552 + 512 + 128, 2, (bf16_t*)(P.ws + WS_BIG + BIG_VT1), lds); }
#endif
#if !defined(ONLY) || ONLY == 12
    PHASE(12) { PSYNC(12); REP(22) for (int ch = blockIdx.x; ch < 256; ch += gridDim.x) ssd_chain(P, lds, ch);
                 REP(23) phase_swa(P, lds); }
#endif
#if !defined(ONLY) || ONLY == 13
    PHASE(13) { PSYNC(13); REP(13) phase_ssd_finish(P); }
#endif
#if !defined(ONLY) || ONLY == 14
    PHASE(14) { PSYNC(14); { EpiResid2 e = make_resid2(P, 1, 2 * 1024, 0, ZB0, ZB0, I_LNFG, I_LNFB, 0); run_gemm(lds, ABUF, (const bf16_t*)(P.ws + WS_WOUT) + (size_t)1024 * 1024, 1024, 1024, true, e); } }
#endif
#if !defined(ONLY) || ONLY == 15
    PHASE(15) { PSYNC(15); phase_rows<1>(P, ZB0, 1, I_LNMG, I_LNMB, 1, 3 * 1024, true); }
#endif
#if !defined(ONLY) || ONLY == 16
    PHASE(16) { PSYNC(16); REP(16) { EpiB16<1> e; e.O = PB; e.ldc = 4096; run_gemm(lds, ABUF, (const bf16_t*)(P.ws + WS_W1) + (size_t)4096 * 1024, 4096, 1024, true, e); } }
#endif
#if !defined(ONLY) || ONLY == 17
    PHASE(17) { PSYNC(17); { EpiResid2 e = make_resid2(P, 1, 5 * 1024, 0, ZB0, ZB1, I_LNMG, I_LNMB, 1); run_gemm(lds, PB, (const bf16_t*)(P.ws + WS_W2) + (size_t)4096 * 1024, 1024, 4096, true, e); } }
#endif
#if !defined(ONLY) || ONLY == 18
    PHASE(18) { PSYNC(18); phase_rows<2>(P, ZB1, 1, I_LNFG, I_LNFB, 0, 0, true); }
#endif
}

#ifndef COOP
#define COOP 1
#endif
extern "C" void kernel_launch(void* const* d_in, const int* in_sizes, int n_in, void* d_out, int out_size, void* d_ws, size_t ws_size, hipStream_t stream) {
    static int grid = 0;
    if (grid == 0) {
        if (n_in != 38 || ws_size < WS_NEED) { fprintf(stderr, "kernel_launch: n_in %d ws %zu need %zu\n", n_in, ws_size, (size_t)WS_NEED); grid = -1; return; }
        int dev = 0, cus = 0, per_cu = 0;
        hipGetDevice(&dev); hipDeviceGetAttribute(&cus, hipDeviceAttributeMultiprocessorCount, dev);
        if (hipFuncSetAttribute((const void*)mega, hipFuncAttributeMaxDynamicSharedMemorySize, LDS_BYTES) != hipSuccess) { fprintf(stderr, "hipFuncSetAttribute failed\n"); grid = -1; return; }
        hipOccupancyMaxActiveBlocksPerMultiprocessor(&per_cu, (const void*)mega, 512, LDS_BYTES);
        (void)hipGetLastError();
        if (per_cu < 1) per_cu = 1;
        grid = cus * 1;
    }
    if (grid < 0) return;
    if (hipMemsetAsync((char*)d_ws + WS_BAR, 0, XCD_BAR_WORDS * 4, stream) != hipSuccess) { fprintf(stderr, "memset failed\n"); return; }
    Params p{};
    for (int i = 0; i < 38; ++i) p.in[i] = (const float*)d_in[i];
    p.out = (float*)d_out; p.ws = (unsigned char*)d_ws;
#if COOP
    p.ph_lo = 0; p.ph_hi = NPH;
    void* args[] = {&p};
    hipError_t e = hipLaunchCooperativeKernel((const void*)mega, dim3(grid), dim3(512), args, LDS_BYTES, stream);
    if (e != hipSuccess) fprintf(stderr, "cooperative launch failed: %s (grid %d)\n", hipGetErrorString(e), grid);
#else
    for (int ph = 0; ph < NPH; ++ph) { p.ph_lo = ph; p.ph_hi = ph + 1; hipLaunchKernelGGL(mega, dim3(grid), dim3(512), LDS_BYTES, stream, p); }
#endif
}
```
